# Optimizing an MI355X kernel written in HIP

```python
import jax, jax.numpy as jnp
from jax import lax
import numpy as np

D_MODEL = 1024
BATCH = 8
SEQ = 4096
DEPTH = 2

N_HEADS = 16
HEAD_DIM = D_MODEL // N_HEADS
N_MIXERS = 2
MOBA_BLOCK = 256
MOBA_TOPK = 3
MOBA_Q_CHUNK = 64
SB_Q_BLOCK = 128
NORM_EPS = 1e-6

kernel_name = "moba_stickbreaking_interleaved_hybrid"


def rms_norm(x, g):
    xf = x.astype(jnp.float32)
    y = xf * lax.rsqrt(jnp.mean(xf * xf, axis=-1, keepdims=True) + NORM_EPS)
    return (y * g.astype(jnp.float32)).astype(x.dtype)


def alibi_slopes(n_heads):
    return jnp.asarray(2.0 ** (-8.0 * np.arange(1, n_heads + 1) / n_heads), dtype=jnp.float32)


def moba_attention(q, k, v):
    b, h, s, dh = q.shape
    n_blk = -(-s // MOBA_BLOCK)
    s_pad = n_blk * MOBA_BLOCK
    pad = ((0, 0), (0, 0), (0, s_pad - s), (0, 0))
    qp, kp, vp = jnp.pad(q, pad), jnp.pad(k, pad), jnp.pad(v, pad)
    k_blk = kp.reshape(b, h, n_blk, MOBA_BLOCK, dh)
    v_blk = vp.reshape(b, h, n_blk, MOBA_BLOCK, dh)
    k_mean = jnp.mean(k_blk.astype(jnp.float32), axis=3)
    n_sel = min(MOBA_TOPK, n_blk - 1)
    n_chunks = s_pad // MOBA_Q_CHUNK
    slopes = alibi_slopes(h)
    scale = dh ** -0.5
    blk_ar = jnp.arange(MOBA_BLOCK)

    def one_chunk(idx):
        bi = idx // n_chunks
        q0 = (idx % n_chunks) * MOBA_Q_CHUNK
        qf = lax.dynamic_slice_in_dim(qp[bi], q0, MOBA_Q_CHUNK, axis=1).astype(jnp.float32)
        cur = q0 // MOBA_BLOCK
        t_pos = q0 + jnp.arange(MOBA_Q_CHUNK)
        kb, vb = k_blk[bi], v_blk[bi]
        own_k = lax.dynamic_index_in_dim(kb, cur, axis=1, keepdims=False).astype(jnp.float32)
        own_v = lax.dynamic_index_in_dim(vb, cur, axis=1, keepdims=False).astype(jnp.float32)
        s_own = cur * MOBA_BLOCK + blk_ar
        dist_own = (t_pos[:, None] - s_own[None, :]).astype(jnp.float32)
        logit_own = jnp.einsum('hqd,hkd->hqk', qf, own_k) * scale - slopes[:, None, None] * dist_own[None]
        logit_own = jnp.where((s_own[None, :] <= t_pos[:, None])[None], logit_own, -jnp.inf)
        if n_sel == 0:
            probs = jax.nn.softmax(logit_own, axis=-1)
            return jnp.einsum('hqk,hkd->hqd', probs, own_v)
        gate = jnp.einsum('hqd,hnd->hqn', qf, k_mean[bi])
        gate = jnp.where((jnp.arange(n_blk) < cur)[None, None, :], gate, -jnp.inf)
        _, sel = lax.top_k(gate, n_sel)
        sel_valid = sel < cur
        k_sel = jax.vmap(lambda kh, ih: kh[ih])(kb, sel).astype(jnp.float32)
        v_sel = jax.vmap(lambda vh, ih: vh[ih])(vb, sel).astype(jnp.float32)
        s_sel = sel[..., None] * MOBA_BLOCK + blk_ar
        dist_sel = (t_pos[None, :, None, None] - s_sel).astype(jnp.float32)
        logit_sel = jnp.einsum('hqd,hqnkd->hqnk', qf, k_sel) * scale - slopes[:, None, None, None] * dist_sel
        logit_sel = jnp.where(sel_valid[..., None], logit_sel, -jnp.inf)
        n_past = n_sel * MOBA_BLOCK
        logits = jnp.concatenate([logit_sel.reshape(h, MOBA_Q_CHUNK, n_past), logit_own], axis=-1)
        probs = jax.nn.softmax(logits, axis=-1)
        p_sel = probs[..., :n_past].reshape(h, MOBA_Q_CHUNK, n_sel, MOBA_BLOCK)
        p_own = probs[..., n_past:]
        return (jnp.einsum('hqnk,hqnkd->hqd', p_sel, v_sel)
                + jnp.einsum('hqk,hkd->hqd', p_own, own_v))

    outs = lax.map(one_chunk, jnp.arange(b * n_chunks))
    outs = outs.reshape(b, n_chunks, h, MOBA_Q_CHUNK, dh).transpose(0, 2, 1, 3, 4)
    return outs.reshape(b, h, s_pad, dh)[:, :, :s].astype(q.dtype)


def stick_breaking_attention(q, k, v):
    b, h, s, dh = q.shape
    n_qb = s // SB_Q_BLOCK
    scale = dh ** -0.5
    s_pos = jnp.arange(s)

    def one_block(idx):
        bi = idx // n_qb
        q0 = (idx % n_qb) * SB_Q_BLOCK
        qf = lax.dynamic_slice_in_dim(q[bi], q0, SB_Q_BLOCK, axis=1).astype(jnp.float32)
        z = jnp.einsum('hqd,hkd->hqk', qf, k[bi].astype(jnp.float32)) * scale
        t_pos = q0 + jnp.arange(SB_Q_BLOCK)
        strict = (s_pos[None, :] < t_pos[:, None])[None]
        log_1m_beta = jnp.where(strict, jax.nn.log_sigmoid(-z), 0.0)
        suffix = lax.cumsum(log_1m_beta, axis=2, reverse=True) - log_1m_beta
        w = jnp.where(strict, jnp.exp(jax.nn.log_sigmoid(z) + suffix), 0.0)
        return jnp.einsum('hqk,hkd->hqd', w, v[bi].astype(jnp.float32))

    outs = lax.map(one_block, jnp.arange(b * n_qb))
    outs = outs.reshape(b, n_qb, h, SB_Q_BLOCK, dh).transpose(0, 2, 1, 3, 4)
    return outs.reshape(b, h, s, dh).astype(q.dtype)


def mixer_branch(hn, w_in, w_out, mixer_id):
    b, s, d = hn.shape
    proj = jnp.einsum('bsd,de->bse', hn, w_in)
    q, k, v, z = jnp.split(proj, 4, axis=-1)
    to_heads = lambda t: t.reshape(b, s, N_HEADS, HEAD_DIM).transpose(0, 2, 1, 3)
    if mixer_id == 0:
        o = moba_attention(to_heads(q), to_heads(k), to_heads(v))
    else:
        o = stick_breaking_attention(to_heads(q), to_heads(k), to_heads(v))
    o = o.transpose(0, 2, 1, 3).reshape(b, s, d)
    return jnp.einsum('bse,ed->bsd', o * jax.nn.silu(z), w_out)


def setup_inputs(seed: int = 0) -> dict:
    key = jax.random.key(seed)
    k_x, k_g, k_in, k_out, k_f = jax.random.split(key, 5)
    x = jax.random.normal(k_x, (BATCH, SEQ, D_MODEL), jnp.float32)
    norm_g = 1.0 + 0.02 * jax.random.normal(k_g, (DEPTH, D_MODEL), jnp.float32)
    w_in = jax.random.normal(k_in, (DEPTH, D_MODEL, 4 * D_MODEL), jnp.float32) * D_MODEL ** -0.5
    w_out = jax.random.normal(k_out, (DEPTH, D_MODEL, D_MODEL), jnp.float32) * D_MODEL ** -0.5
    final_g = 1.0 + 0.02 * jax.random.normal(k_f, (D_MODEL,), jnp.float32)
    return {"x": x, "norm_g": norm_g, "w_in": w_in, "w_out": w_out, "final_g": final_g}


def reference(x, norm_g, w_in, w_out, final_g):
    h = x
    for i in range(DEPTH):
        h = h + mixer_branch(rms_norm(h, norm_g[i]), w_in[i], w_out[i], i % N_MIXERS)
    return rms_norm(h, final_g)
```

```cpp
#include <hip/hip_runtime.h>
#include <cstdio>
#include <cstdint>
#include <cmath>

#ifndef MK_N_LAUNCHES
#define MK_N_LAUNCHES 8
#endif
namespace pg8 {
#define PG8_LAS __attribute__((address_space(3)))
typedef unsigned short bf16_t;
typedef short bf16x8 __attribute__((ext_vector_type(8)));
typedef float f32x4 __attribute__((ext_vector_type(4)));
typedef unsigned u32x4 __attribute__((ext_vector_type(4)));
constexpr int BM = 256, BK = 64, HALF = 128, HTB = HALF * BK * 2  , STAGE_BYTES = 8 * HTB, NXCD = 8, WGM = 8;

__host__ __device__ __forceinline__ int lds_byte(int r, int c) { const int st = (r >> 4) * 2 + (c >> 5), rr = r & 15, cc = c & 31, ob = rr * 64 + cc * 2; return st * 1024 + (ob ^ (((ob >> 9) & 1) << 5)); }
__host__ __device__ __forceinline__ void stage_rc(int b, int& R, int& C) { const int st = b / 1024, sb = b % 1024, swz = sb ^ (((sb >> 9) & 1) << 5); R = (st >> 1) * 16 + swz / 64; C = (st & 1) * 32 + (swz % 64) / 2; }
__host__ __device__ __forceinline__ int perm32(int rho) { const int n = rho >> 4, i = rho & 15; return 8 * (i >> 2) + 4 * n + (i & 3); }

struct Unit { int pm, pn; };
struct Gemm { const bf16_t* A; const bf16_t* Bt; int M, N, K; };

struct StaticOrder {
    int nM, nN, nwg, G, c;
    __host__ __device__ void init(int M, int N, int G_, int c_) { nM = M / BM; nN = N / BM; nwg = nM * nN; G = G_; c = c_; }
    __host__ __device__ bool next(int i, Unit& u) const {
        const long L = (long)i * G + c; if (L >= nwg) return false;
        int wgid = (int)L; { const int q = nwg / NXCD, r = nwg % NXCD, xcd = wgid % NXCD, off = wgid / NXCD; wgid = (xcd < r ? xcd * (q + 1) : r * (q + 1) + (xcd - r) * q) + off; }
        const int nig = WGM * nN, gid = wgid / nig, fm = gid * WGM, gsz = (nM - fm) < WGM ? (nM - fm) : WGM;
        u.pm = fm + ((wgid % nig) % gsz); u.pn = (wgid % nig) / gsz; return true;
    }
    __device__ __forceinline__ void a_ready(const Unit&) const {}
    __device__ __forceinline__ void done(const Unit&) const {}
};

}
constexpr int BATCH = 8, SEQ = 4096, DM = 1024, NH = 16, HD = 64, MROWS = BATCH * SEQ, NIN = 4 * DM, DEPTH = 2;
constexpr int MBLK = 256, NBLK = SEQ / MBLK;
constexpr float NORM_EPS = 1e-6f;
constexpr float LOG2E = 1.4426950408889634f;
constexpr float QSCALE = 0.125f * LOG2E;
constexpr size_t TSTRIDE = (size_t)MROWS * DM;

namespace pg8 {
__device__ __forceinline__ unsigned cvt_pk_bf16(float lo, float hi) { unsigned r; asm volatile("v_cvt_pk_bf16_f32 %0, %1, %2" : "=v"(r) : "v"(lo), "v"(hi)); return r; }
typedef unsigned u32x2 __attribute__((ext_vector_type(2)));

template <int LAYER> struct EpiQKVZ {
    static constexpr bool PERM = true, AFTER_DRAIN = false;
    bf16_t* QKVZ; const float* rstd0; const float* ssq; float* kmeanP;
    __device__ __forceinline__ void operator()(const f32x4 (&acc)[2][2][4][2], const Unit& u, int wr, int wc, int fr, int fq, int tid) const {
        const int t = u.pn >> 2, colt = (u.pn & 3) * BM;
        bf16_t* base = QKVZ + (size_t)t * TSTRIDE;
        const float sc = (t == 0) ? QSCALE : 1.f;
        const int row0 = u.pm * BM + wr * 64 + fr, col0 = colt + wc * 32 + 8 * fq;
        float rs[2][4];
#pragma unroll
        for (int ai = 0; ai < 2; ++ai)
#pragma unroll
            for (int m = 0; m < 4; ++m) { const int row = row0 + ai * HALF + m * 16;
                if (LAYER == 0) rs[ai][m] = rstd0[row] * sc;
                else { const float s = (ssq[row] + ssq[MROWS + row]) + (ssq[2 * MROWS + row] + ssq[3 * MROWS + row]); rs[ai][m] = (1.0f / sqrtf(s * (1.0f / DM) + NORM_EPS)) * sc; } }
        const bool km = (LAYER == 0) && (t == 1);
        f32x4 cs[2][2];
#pragma unroll
        for (int bj = 0; bj < 2; ++bj)
#pragma unroll
            for (int n = 0; n < 2; ++n) cs[bj][n] = (f32x4){0.f, 0.f, 0.f, 0.f};
#pragma unroll
        for (int ai = 0; ai < 2; ++ai)
#pragma unroll
            for (int m = 0; m < 4; ++m) { bf16_t* rowp = base + (size_t)(row0 + ai * HALF + m * 16) * DM + col0; const float r = rs[ai][m];
#pragma unroll
                for (int bj = 0; bj < 2; ++bj) { const f32x4 v0 = acc[ai][bj][m][0] * r, v1 = acc[ai][bj][m][1] * r;
                    if (LAYER == 0 && km) { cs[bj][0] += v0; cs[bj][1] += v1; }
                    u32x4 w; w.x = cvt_pk_bf16(v0[0], v0[1]); w.y = cvt_pk_bf16(v0[2], v0[3]); w.z = cvt_pk_bf16(v1[0], v1[1]); w.w = cvt_pk_bf16(v1[2], v1[3]);
                    *(u32x4*)(rowp + bj * HALF) = w; } }
        if (LAYER == 0) { if (km) {
#pragma unroll
            for (int bj = 0; bj < 2; ++bj)
#pragma unroll
                for (int n = 0; n < 2; ++n)
#pragma unroll
                    for (int e = 0; e < 4; ++e) { float s = cs[bj][n][e]; s += __shfl_xor(s, 1); s += __shfl_xor(s, 2); s += __shfl_xor(s, 4); s += __shfl_xor(s, 8); cs[bj][n][e] = s; }
            if (fr == 0) { float* kp = kmeanP + ((size_t)wr * (BATCH * NBLK) + u.pm) * DM + colt + wc * 32 + 8 * fq;
#pragma unroll
                for (int bj = 0; bj < 2; ++bj) { *(f32x4*)(kp + bj * HALF) = cs[bj][0]; *(f32x4*)(kp + bj * HALF + 4) = cs[bj][1]; } } } }
    }
};

template <bool WRITE_BF16> struct EpiRes {
    static constexpr bool PERM = false, AFTER_DRAIN = false;
    const float* base; float* out; bf16_t* hb; float* ssq; PG8_LAS float* red;
    __device__ __forceinline__ void operator()(const f32x4 (&acc)[2][2][4][2], const Unit& u, int wr, int wc, int fr, int fq, int tid) const {
        const int col0 = u.pn * BM + wc * 32 + 4 * fq;
#pragma unroll
        for (int ai = 0; ai < 2; ++ai)
#pragma unroll
            for (int m = 0; m < 4; ++m) { const int r = ai * HALF + wr * 64 + m * 16 + fr; const size_t off = (size_t)(u.pm * BM + r) * DM + col0; float s = 0.f;
#pragma unroll
                for (int bj = 0; bj < 2; ++bj)
#pragma unroll
                    for (int n = 0; n < 2; ++n) { const f32x4 bs = *(const f32x4*)(base + off + bj * HALF + n * 16); const f32x4 o = bs + acc[ai][bj][m][n];
                        *(f32x4*)(out + off + bj * HALF + n * 16) = o; s += (o[0] * o[0] + o[1] * o[1]) + (o[2] * o[2] + o[3] * o[3]);
                        if (WRITE_BF16) { u32x2 w; w.x = cvt_pk_bf16(o[0], o[1]); w.y = cvt_pk_bf16(o[2], o[3]); *(u32x2*)(hb + off + bj * HALF + n * 16) = w; } }
                s += __shfl_xor(s, 16); s += __shfl_xor(s, 32);
                if (fq == 0) red[r * 4 + wc] = s;
                if (m & 1) asm volatile("" ::: "memory"); }
        asm volatile("s_waitcnt lgkmcnt(0)" ::: "memory"); __builtin_amdgcn_s_barrier(); asm volatile("" ::: "memory");
        if (tid < BM) { const PG8_LAS f32x4* p = (const PG8_LAS f32x4*)red + tid; const f32x4 v = *p; ssq[(size_t)u.pn * MROWS + u.pm * BM + tid] = (v[0] + v[1]) + (v[2] + v[3]); }
    }
};
}
namespace pg8 {
template <class Epi, class Sched, bool ALIGN_EPI = false, bool SP2 = false>
__device__ __forceinline__ void gemm_phase(PG8_LAS unsigned char* lds, const Gemm g, const Sched& S, const Epi& E) {
    const int tid = threadIdx.x, wid = __builtin_amdgcn_readfirstlane(tid >> 6), lane = tid & 63, wr = wid >> 2, wc = wid & 3, fr = lane & 15, fq = lane >> 4;
    const int K = g.K, nt = K / BK;
    unsigned voffA[2], voffB[2];
#pragma unroll
    for (int i = 0; i < 2; ++i) { int R, C; stage_rc(tid * 16 + i * 8192, R, C); const int Rb = Epi::PERM ? ((R & ~31) + perm32(R & 31)) : R;
        voffA[i] = (unsigned)(R * K + C) * 2u; voffB[i] = (unsigned)(Rb * K + C) * 2u; }
    const size_t kstep = (size_t)(BK * 2);
    const size_t hstep = (size_t)HALF * K * 2;
    const size_t tstep = 2 * hstep;
    const unsigned ldsw = (unsigned)wid * 1024u;
    const int aoff = lds_byte(wr * 64 + fr, fq * 8), boff = lds_byte(wc * 32 + fr, fq * 8);
#define PG8_SA(b, h) (((b) * 2 + (h)) * HTB)
#define PG8_SB(b, h) ((4 + (b) * 2 + (h)) * HTB)
#define PG8_STAGE(bufoff, gbase, voff) do { _Pragma("unroll") for (int _i = 0; _i < 2; ++_i) \
        __builtin_amdgcn_global_load_lds((const unsigned*)((const char*)(gbase) + (voff)[_i]), (PG8_LAS unsigned*)(lds + (bufoff) + ldsw + _i * 8192), 16, 0, 0); } while (0)
#define PG8_LDA(dst, b, h) do { _Pragma("unroll") for (int m = 0; m < 4; ++m) _Pragma("unroll") for (int k = 0; k < 2; ++k) dst[m][k] = *(const PG8_LAS bf16x8*)(lds + PG8_SA(b, h) + aoff + m * 2048 + k * 1024); } while (0)
#define PG8_LDB(dst, b, h) do { _Pragma("unroll") for (int n = 0; n < 2; ++n) _Pragma("unroll") for (int k = 0; k < 2; ++k) dst[n][k] = *(const PG8_LAS bf16x8*)(lds + PG8_SB(b, h) + boff + n * 2048 + k * 1024); } while (0)
#define PG8_MMA(ai, bj, At, Bt) do { __builtin_amdgcn_s_setprio(1); _Pragma("unroll") for (int m = 0; m < 4; ++m) _Pragma("unroll") for (int n = 0; n < 2; ++n) _Pragma("unroll") for (int k = 0; k < 2; ++k) \
        acc[ai][bj][m][n] = __builtin_amdgcn_mfma_f32_16x16x32_bf16(Bt[n][k], At[m][k], acc[ai][bj][m][n], 0, 0, 0); __builtin_amdgcn_s_setprio(0); } while (0)
#define PG8_WAIT_V(n) asm volatile("s_waitcnt vmcnt(" #n ")" ::: "memory")
#define PG8_WAIT_L(n) asm volatile("s_waitcnt lgkmcnt(" #n ")" ::: "memory")
#define PG8_BAR __builtin_amdgcn_s_barrier()
#define PG8_SCHED __builtin_amdgcn_sched_barrier(0)
    Unit cur, nxt; int ui = 0;
    if (!S.next(0, cur)) return;
    f32x4 acc[2][2][4][2];
#pragma unroll
    for (int a = 0; a < 2; ++a)
#pragma unroll
        for (int b = 0; b < 2; ++b)
#pragma unroll
            for (int m = 0; m < 4; ++m)
#pragma unroll
                for (int n = 0; n < 2; ++n) acc[a][b][m][n] = (f32x4){0.f, 0.f, 0.f, 0.f};
    bf16x8 At[4][2], B0[2][2], B1[2][2];
    const char* cA = (const char*)g.A + (size_t)cur.pm * tstep; const char* cB = (const char*)g.Bt + (size_t)cur.pn * tstep;
    S.a_ready(cur);
    if constexpr (SP2) {
        PG8_STAGE(PG8_SB(0, 0), cB, voffB); PG8_STAGE(PG8_SB(0, 1), cB + hstep, voffB); PG8_STAGE(PG8_SA(0, 0), cA, voffA); PG8_STAGE(PG8_SA(0, 1), cA + hstep, voffA);
        if (wr == 1) PG8_BAR;
        PG8_WAIT_V(2); PG8_BAR;
        PG8_STAGE(PG8_SB(1, 0), cB + kstep, voffB); PG8_STAGE(PG8_SA(1, 0), cA + kstep, voffA); PG8_STAGE(PG8_SB(1, 1), cB + hstep + kstep, voffB);
        PG8_WAIT_V(6); PG8_BAR;
    } else {
        PG8_STAGE(PG8_SB(0, 0), cB, voffB); PG8_STAGE(PG8_SA(0, 0), cA, voffA); PG8_STAGE(PG8_SB(0, 1), cB + hstep, voffB); PG8_STAGE(PG8_SA(0, 1), cA + hstep, voffA);
        if (wr == 1) PG8_BAR;
        PG8_WAIT_V(4); PG8_BAR;
        PG8_STAGE(PG8_SB(1, 0), cB + kstep, voffB); PG8_STAGE(PG8_SA(1, 0), cA + kstep, voffA); PG8_STAGE(PG8_SB(1, 1), cB + hstep + kstep, voffB);
        PG8_WAIT_V(6); PG8_BAR;
    }
    for (;;) {
        const bool has_next = S.next(ui + 1, nxt);
        const char* nA = has_next ? (const char*)g.A + (size_t)nxt.pm * tstep : cA; const char* nB = has_next ? (const char*)g.Bt + (size_t)nxt.pn * tstep : cB;
        for (int t = 0; t < nt; t += 2) {
            const bool last = (t == nt - 2);
            const char* a1 = cA + (size_t)(t + 1) * kstep;
            const char* a2 = last ? nA : cA + (size_t)(t + 2) * kstep; const char* b2 = last ? nB : cB + (size_t)(t + 2) * kstep;
            const char* a3 = a2 + kstep; const char* b3 = b2 + kstep;
            if (last && has_next) S.a_ready(nxt);
            if constexpr (SP2) {
            PG8_LDB(B0, 0, 0); PG8_LDB(B1, 0, 1); PG8_SCHED; PG8_LDA(At, 0, 0); PG8_STAGE(PG8_SA(1, 1), a1 + hstep, voffA);
            PG8_WAIT_V(8); PG8_WAIT_L(0); PG8_BAR; PG8_MMA(0, 0, At, B0); PG8_MMA(0, 1, At, B1); PG8_BAR; PG8_SCHED;
            PG8_LDA(At, 0, 1); PG8_STAGE(PG8_SB(0, 0), b2, voffB); PG8_STAGE(PG8_SB(0, 1), b2 + hstep, voffB); PG8_STAGE(PG8_SA(0, 0), a2, voffA);
            PG8_WAIT_V(8); PG8_WAIT_L(0); PG8_BAR; PG8_MMA(1, 0, At, B0); PG8_MMA(1, 1, At, B1); PG8_BAR; PG8_SCHED;
            PG8_LDB(B0, 1, 0); PG8_LDB(B1, 1, 1); PG8_SCHED; PG8_LDA(At, 1, 0); PG8_STAGE(PG8_SA(0, 1), a2 + hstep, voffA);
            PG8_WAIT_V(8); PG8_WAIT_L(0); PG8_BAR; PG8_MMA(0, 0, At, B0); PG8_MMA(0, 1, At, B1); PG8_BAR; PG8_SCHED;
            PG8_LDA(At, 1, 1); PG8_STAGE(PG8_SB(1, 0), b3, voffB); PG8_STAGE(PG8_SB(1, 1), b3 + hstep, voffB); PG8_STAGE(PG8_SA(1, 0), a3, voffA);
            PG8_WAIT_V(8); PG8_WAIT_L(0); PG8_BAR; PG8_MMA(1, 0, At, B0); PG8_MMA(1, 1, At, B1); PG8_BAR; PG8_SCHED;
            } else {
            PG8_LDB(B0, 0, 0); PG8_SCHED; PG8_LDA(At, 0, 0); PG8_STAGE(PG8_SA(1, 1), a1 + hstep, voffA);
            PG8_WAIT_L(8); PG8_BAR; PG8_WAIT_L(0); PG8_MMA(0, 0, At, B0); PG8_BAR; PG8_SCHED;
            PG8_LDB(B1, 0, 1); PG8_STAGE(PG8_SB(0, 0), b2, voffB);
            PG8_BAR; PG8_WAIT_L(0); PG8_MMA(0, 1, At, B1); PG8_BAR;
            PG8_LDA(At, 0, 1); PG8_STAGE(PG8_SA(0, 0), a2, voffA);
            PG8_BAR; PG8_WAIT_L(0); PG8_MMA(1, 0, At, B0); PG8_BAR; PG8_SCHED;
            PG8_STAGE(PG8_SB(0, 1), b2 + hstep, voffB);
            PG8_WAIT_V(6); PG8_BAR; PG8_MMA(1, 1, At, B1); PG8_BAR;
            PG8_LDB(B0, 1, 0); PG8_SCHED; PG8_LDA(At, 1, 0); PG8_STAGE(PG8_SA(0, 1), a2 + hstep, voffA);
            PG8_WAIT_L(8); PG8_BAR; PG8_WAIT_L(0); PG8_MMA(0, 0, At, B0); PG8_BAR; PG8_SCHED;
            PG8_LDB(B1, 1, 1); PG8_STAGE(PG8_SB(1, 0), b3, voffB);
            PG8_BAR; PG8_WAIT_L(0); PG8_MMA(0, 1, At, B1); PG8_BAR;
            PG8_LDA(At, 1, 1); PG8_STAGE(PG8_SA(1, 0), a3, voffA);
            PG8_BAR; PG8_WAIT_L(0); PG8_MMA(1, 0, At, B0); PG8_BAR; PG8_SCHED;
            PG8_STAGE(PG8_SB(1, 1), b3 + hstep, voffB);
            PG8_WAIT_V(6); PG8_BAR; PG8_MMA(1, 1, At, B1); PG8_BAR;
            }
        }
        if constexpr (ALIGN_EPI) { if (wr == 0) PG8_BAR; }
        if constexpr (!Epi::AFTER_DRAIN) { E(acc, cur, wr, wc, fr, fq, tid); S.done(cur); }
        if (!has_next) break;
#pragma unroll
        for (int a = 0; a < 2; ++a)
#pragma unroll
            for (int b = 0; b < 2; ++b)
#pragma unroll
                for (int m = 0; m < 4; ++m)
#pragma unroll
                    for (int n = 0; n < 2; ++n) acc[a][b][m][n] = (f32x4){0.f, 0.f, 0.f, 0.f};
        cur = nxt; cA = nA; cB = nB; ++ui;
        if constexpr (ALIGN_EPI) { if (wr == 1) PG8_BAR; }
    }
    PG8_WAIT_V(0);
    if constexpr (!ALIGN_EPI) { if (wr == 0) PG8_BAR; }
    PG8_BAR;
    static_assert(!Epi::AFTER_DRAIN, "no after-drain epilogues here");
#undef PG8_SA
#undef PG8_SB
#undef PG8_STAGE
#undef PG8_LDA
#undef PG8_LDB
#undef PG8_MMA
#undef PG8_WAIT_V
#undef PG8_WAIT_L
#undef PG8_BAR
#undef PG8_SCHED
}
}
#define GAS __attribute__((address_space(1)))
#define LAS __attribute__((address_space(3)))
typedef unsigned short bf16;
typedef unsigned v4u __attribute__((ext_vector_type(4)));
typedef float f32x4 __attribute__((ext_vector_type(4)));
typedef short bf16x8 __attribute__((ext_vector_type(8)));
typedef GAS unsigned gu32;
typedef GAS unsigned long long gu64;
#define RLX_AGENT __ATOMIC_RELAXED, __HIP_MEMORY_SCOPE_AGENT
#define LDS_WAIT() asm volatile("s_waitcnt lgkmcnt(0)" ::: "memory")
#define VM_WAIT() asm volatile("s_waitcnt vmcnt(0)" ::: "memory")
__device__ __forceinline__ unsigned long long rt() { return __builtin_amdgcn_s_memrealtime(); }
__device__ __forceinline__ unsigned f2bf(float f) { unsigned u = __builtin_bit_cast(unsigned, f); return (u + 0x7fffu + ((u >> 16) & 1u)) >> 16; }
__device__ __forceinline__ unsigned pk2(float lo, float hi) { return f2bf(lo) | (f2bf(hi) << 16); }

#define XB_TMO      128
#define XB_XCNT(j)  (256  + 64 * (j))
#define XB_XSUB(j)  (1280 + 64 * (j))
#define XB_XGEN(j)  (2304 + 64 * (j))
#define XB_TOP      3328
#define XB_TOPGEN   3392
#define XCD_BAR_WORDS 3456
#define XB_SPIN_CAP (1u << 22)

__device__ __forceinline__ unsigned xb_ld(unsigned* p)              { return __hip_atomic_load(p, __ATOMIC_RELAXED, __HIP_MEMORY_SCOPE_AGENT); }
__device__ __forceinline__ unsigned xb_add(unsigned* p, unsigned v) { return __hip_atomic_fetch_add(p, v, __ATOMIC_RELAXED, __HIP_MEMORY_SCOPE_AGENT); }
__device__ __forceinline__ unsigned xb_xcc_id() { return (unsigned)__builtin_amdgcn_s_getreg((3 << 11) | 20) & 0xFu; }
#define XB_SPIN(cond, bar) do { unsigned _sp = 0; while (cond) { __builtin_amdgcn_s_sleep(1); \
    if ((++_sp & 255u) == 0u) { if (xb_ld(&(bar)[XB_TMO])) break; if (_sp > XB_SPIN_CAP) { atomicAdd(&(bar)[XB_TMO], 1u); break; } } } } while (0)

struct XcdBarrier {
    unsigned* bar; unsigned x;
    volatile LAS unsigned* st;
};

__device__ __forceinline__ XcdBarrier xcd_barrier_post(unsigned* bar, volatile LAS unsigned* st) {
    XcdBarrier b; b.bar = bar; b.x = xb_xcc_id(); b.st = st;
    if (threadIdx.x == 0) (void)xb_add(&bar[XB_XCNT(b.x)], 1u);
    return b;
}
__device__ __forceinline__ void xcd_barrier_complete(unsigned* bar, unsigned x, unsigned& nloc, unsigned& nx) {
    const unsigned G = gridDim.x * gridDim.y * gridDim.z;
    unsigned sum, cnt, mine, sp = 0u;
    for (;;) {
        sum = 0u; cnt = 0u; mine = 0u;
#pragma unroll
        for (unsigned j = 0; j < 16; ++j) { const unsigned c = xb_ld(&bar[XB_XCNT(j)]); sum += c; cnt += (c > 0u) ? 1u : 0u; mine = (j == x) ? c : mine; }
        if (sum == G) break;
        __builtin_amdgcn_s_sleep(1);
        if ((++sp & 255u) == 0u) { if (xb_ld(&bar[XB_TMO])) break; if (sp > XB_SPIN_CAP) { atomicAdd(&bar[XB_TMO], 1u); break; } }
    }
    nloc = mine > 0u ? mine : 1u; nx = cnt > 0u ? cnt : 1u;
}

__device__ __forceinline__ void xcd_barrier(const XcdBarrier& b) {
    asm volatile("s_waitcnt vmcnt(0)" ::: "memory");
    __syncthreads();
    if (threadIdx.x == 0) {
        unsigned* bar = b.bar;
        __builtin_amdgcn_s_waitcnt(0);
        unsigned nloc = b.st[0], nx = b.st[1];
        if (nloc == 0u) { xcd_barrier_complete(bar, b.x, nloc, nx); b.st[0] = nloc; b.st[1] = nx; }
        const unsigned old = xb_add(&bar[XB_XSUB(b.x)], 1u);
        const unsigned gen = old / nloc;
        if (old + 1u == (gen + 1u) * nloc) {
            __builtin_amdgcn_fence(__ATOMIC_RELEASE, "agent");
            asm volatile("s_waitcnt vmcnt(0)" ::: "memory");
            const unsigned og = xb_add(&bar[XB_TOP], 1u);
            const unsigned tg = og / nx;
            if (og + 1u == (tg + 1u) * nx) xb_add(&bar[XB_TOPGEN], 1u);
            else XB_SPIN(xb_ld(&bar[XB_TOPGEN]) == tg, bar);
            __builtin_amdgcn_fence(__ATOMIC_ACQUIRE, "agent");
            xb_add(&bar[XB_XGEN(b.x)], 1u);
            asm volatile("s_waitcnt vmcnt(0)" ::: "memory");
        } else {
            XB_SPIN(xb_ld(&bar[XB_XGEN(b.x)]) == gen, bar);
            __builtin_amdgcn_fence(__ATOMIC_ACQUIRE, "agent");
            asm volatile("s_waitcnt vmcnt(0)" ::: "memory");
        }
    }
    __syncthreads();
}
constexpr int NWAVES = 8;
constexpr int N_LAUNCHES = MK_N_LAUNCHES;
constexpr int PER_PHASE = 8;
constexpr size_t MiB = 1u << 20;
constexpr size_t WS_CTL = 0, CTL_ZERO_BYTES = 1 * MiB;
constexpr size_t WS_WIN = 2 * MiB;
constexpr size_t WS_WOUT = 18 * MiB;
constexpr size_t WS_RSTD0 = 22 * MiB;
constexpr size_t WS_SSQ1 = WS_RSTD0 + 512 * 1024;
constexpr size_t WS_SSQ2 = WS_SSQ1 + 512 * 1024;
constexpr size_t WS_KMEAN = 24 * MiB;
constexpr size_t WS_XB = 32 * MiB;
constexpr size_t WS_QKVZ = 96 * MiB;
constexpr size_t WS_OG = 352 * MiB;
constexpr size_t WS_END = 416 * MiB;
constexpr int CW_BAR = 4096;

constexpr int RING_OFF = 0, RING_BYTES = 131072;
constexpr int LDSCTL_OFF = RING_BYTES, MISC_OFF = LDSCTL_OFF + 320;
constexpr int EPI_OFF = RING_BYTES + 1024;
constexpr int LDS_BYTES = 147456;
static_assert(EPI_OFF + 4096 <= LDS_BYTES && MISC_OFF + 128 <= EPI_OFF, "LDS map");

struct Frame {
    LAS unsigned char* lds;
    volatile LAS unsigned* MISC;
    gu32* ctl;
    int tid, lane, wave, vcu, G;
};

__device__ __forceinline__ int vzero() { int z; asm volatile("v_mov_b32 %0, 0" : "=v"(z)); return z; }
__device__ __forceinline__ float bf_lo(unsigned u) { return __builtin_bit_cast(float, u << 16); }
__device__ __forceinline__ float bf_hi(unsigned u) { return __builtin_bit_cast(float, u & 0xffff0000u); }
__device__ __forceinline__ float wave_sum(float v) {
#pragma unroll
    for (int o = 1; o < 64; o <<= 1) v += __shfl_xor(v, o);
    return v;
}

__device__ __forceinline__ void p0_transpose_item(const float* W, const float* g, int K, int N, bf16* WT, LAS float* scr, int item, int lane) {
    const int nblk = N / 32, kb = item / nblk, nb = item % nblk, k0 = 64 * kb, n0 = 32 * nb;
#pragma unroll 8
    for (int i = 0; i < 32; ++i) { const int kk = 2 * i + (lane >> 5); const float sc = g ? g[k0 + kk] : 1.f; scr[kk * 33 + (lane & 31)] = W[(size_t)(k0 + kk) * N + n0 + (lane & 31)] * sc; }
    LDS_WAIT(); asm volatile("" ::: "memory");
    const int c = lane & 7;
#pragma unroll
    for (int j = 0; j < 4; ++j) { const int n = (lane >> 3) + 8 * j; const LAS float* s = scr + (8 * c) * 33 + n;
        v4u o; o.x = pk2(s[0 * 33], s[1 * 33]); o.y = pk2(s[2 * 33], s[3 * 33]); o.z = pk2(s[4 * 33], s[5 * 33]); o.w = pk2(s[6 * 33], s[7 * 33]);
        *(GAS v4u*)(WT + (size_t)(n0 + n) * K + k0 + 8 * c) = o; }
    LDS_WAIT(); asm volatile("" ::: "memory");
}
__device__ __forceinline__ void p0_prologue(Frame& F, const float* x, const float* norm_g, const float* w_in, const float* w_out, unsigned char* ws) {
    LAS float* scr = (LAS float*)(F.lds + RING_OFF + F.wave * 16384);
    const int gw = F.vcu * NWAVES + F.wave, NGW = F.G * NWAVES;
    constexpr int I_IN = (DM / 64) * (NIN / 32), I_OUT = (DM / 64) * (DM / 32);
    constexpr int NITEMS = DEPTH * (I_IN + I_OUT);
    for (int it = gw; it < NITEMS; it += NGW) {
        int r = it; const int l = r / (I_IN + I_OUT); r -= l * (I_IN + I_OUT);
        if (r < I_IN) p0_transpose_item(w_in + (size_t)l * DM * NIN, norm_g + l * DM, DM, NIN, (bf16*)(ws + WS_WIN) + (size_t)l * NIN * DM, scr, r, F.lane);
        else p0_transpose_item(w_out + (size_t)l * DM * DM, nullptr, DM, DM, (bf16*)(ws + WS_WOUT) + (size_t)l * DM * DM, scr, r - I_IN, F.lane);
    }
    bf16* XB = (bf16*)(ws + WS_XB); float* rstd0 = (float*)(ws + WS_RSTD0);
    for (int m = gw; m < MROWS; m += NGW) {
        const GAS f32x4* xr = (const GAS f32x4*)(x + (size_t)m * DM) + F.lane; f32x4 v[4]; float s = 0.f;
#pragma unroll
        for (int j = 0; j < 4; ++j) { v[j] = xr[64 * j]; s += (v[j].x * v[j].x + v[j].y * v[j].y) + (v[j].z * v[j].z + v[j].w * v[j].w); }
        s = wave_sum(s);
        if (F.lane == 0) rstd0[m] = 1.0f / sqrtf(s * (1.0f / DM) + NORM_EPS);
        GAS unsigned long long* o8 = (GAS unsigned long long*)(XB + (size_t)m * DM) + F.lane;
#pragma unroll
        for (int j = 0; j < 4; ++j) o8[64 * j] = (unsigned long long)pk2(v[j].x, v[j].y) | ((unsigned long long)pk2(v[j].z, v[j].w) << 32);
    }
}

__device__ __forceinline__ float dot8(const v4u w, const float* q) {
    return (bf_lo(w.x) * q[0] + bf_hi(w.x) * q[1]) + (bf_lo(w.y) * q[2] + bf_hi(w.y) * q[3]) + (bf_lo(w.z) * q[4] + bf_hi(w.z) * q[5]) + (bf_lo(w.w) * q[6] + bf_hi(w.w) * q[7]);
}
__device__ __forceinline__ void gate_store(const float (&o)[64], float scale, const bf16* zrow, bf16* orow) {
#pragma unroll
    for (int i = 0; i < 8; ++i) { const v4u zw = ((const v4u*)zrow)[i]; float zz[8] = {bf_lo(zw.x), bf_hi(zw.x), bf_lo(zw.y), bf_hi(zw.y), bf_lo(zw.z), bf_hi(zw.z), bf_lo(zw.w), bf_hi(zw.w)}; float r[8];
#pragma unroll
        for (int e = 0; e < 8; ++e) { const float sg = 1.0f / (1.0f + __expf(-zz[e])); r[e] = o[8 * i + e] * scale * zz[e] * sg; }
        v4u ow; ow.x = pk2(r[0], r[1]); ow.y = pk2(r[2], r[3]); ow.z = pk2(r[4], r[5]); ow.w = pk2(r[6], r[7]); ((v4u*)orow)[i] = ow; }
}
__device__ __forceinline__ void moba_simple_phase(Frame& F, const bf16* Q, const bf16* K, const bf16* V, const bf16* Z, const float* kmeanP, bf16* OG) {
    const int gw = F.vcu * NWAVES + F.wave, NGW = F.G * NWAVES; const int vz = vzero();
    for (int it = gw; it < BATCH * NH * (SEQ / 64); it += NGW) {
        const int ch = it & 63, bh = it >> 6, h = bh & 15, b = bh >> 4; const int t = ch * 64 + F.lane, cur = ch >> 2; const size_t rowbase = (size_t)b * SEQ;
        float q[64];
        { const v4u* qp = (const v4u*)(Q + (rowbase + t) * DM + h * HD);
#pragma unroll
          for (int i = 0; i < 8; ++i) { const v4u w = qp[i]; q[8 * i] = bf_lo(w.x); q[8 * i + 1] = bf_hi(w.x); q[8 * i + 2] = bf_lo(w.y); q[8 * i + 3] = bf_hi(w.y); q[8 * i + 4] = bf_lo(w.z); q[8 * i + 5] = bf_hi(w.z); q[8 * i + 6] = bf_lo(w.w); q[8 * i + 7] = bf_hi(w.w); } }
        const float slope2 = exp2f(-0.5f * (float)(h + 1)) * LOG2E;
        float v1 = -INFINITY, v2 = -INFINITY, v3 = -INFINITY; int i1 = -1, i2 = -1, i3 = -1;
        for (int n = 0; n < cur; ++n) {
            const float* k0 = kmeanP + (size_t)(b * NBLK + n) * DM + h * HD + vz; const float* k1 = k0 + (size_t)BATCH * NBLK * DM; float g = 0.f;
#pragma unroll
            for (int d = 0; d < 64; d += 4) { const f32x4 a = *(const f32x4*)(k0 + d), c = *(const f32x4*)(k1 + d); g += (q[d] * (a.x + c.x) + q[d + 1] * (a.y + c.y)) + (q[d + 2] * (a.z + c.z) + q[d + 3] * (a.w + c.w)); }
            if (g > v1) { v3 = v2; i3 = i2; v2 = v1; i2 = i1; v1 = g; i1 = n; } else if (g > v2) { v3 = v2; i3 = i2; v2 = g; i2 = n; } else if (g > v3) { v3 = g; i3 = n; }
        }
        unsigned sel = 0u; if (i1 >= 0) sel |= 1u << i1; if (i2 >= 0) sel |= 1u << i2; if (i3 >= 0) sel |= 1u << i3;
        float m = -INFINITY, l = 0.f, o[64];
#pragma unroll
        for (int d = 0; d < 64; ++d) o[d] = 0.f;
        for (int n = 0; n <= cur; ++n) {
            const bool act = (n == cur) || ((sel >> n) & 1u);
            if (!__any(act)) continue;
            const int s_end = (n == cur) ? (ch & 3) * 64 + 63 : 255;
            for (int sl = 0; sl <= s_end; ++sl) {
                const int s = n * MBLK + sl; const v4u* kr = (const v4u*)(K + (rowbase + s) * DM + h * HD + vz); const v4u* vr = (const v4u*)(V + (rowbase + s) * DM + h * HD + vz);
                float x = 0.f;
#pragma unroll
                for (int i = 0; i < 8; ++i) x += dot8(kr[i], q + 8 * i);
                x += slope2 * (float)(s - t);
                const bool valid = act && (s <= t);
                const float xe = valid ? x : -INFINITY; const float mn = fmaxf(m, xe);
                const float al = (m == mn) ? 1.f : __builtin_amdgcn_exp2f(m - mn); const float p = valid ? __builtin_amdgcn_exp2f(x - mn) : 0.f;
                l = l * al + p; m = mn;
#pragma unroll
                for (int i = 0; i < 8; ++i) { const v4u w = vr[i];
                    o[8 * i] = o[8 * i] * al + p * bf_lo(w.x); o[8 * i + 1] = o[8 * i + 1] * al + p * bf_hi(w.x); o[8 * i + 2] = o[8 * i + 2] * al + p * bf_lo(w.y); o[8 * i + 3] = o[8 * i + 3] * al + p * bf_hi(w.y);
                    o[8 * i + 4] = o[8 * i + 4] * al + p * bf_lo(w.z); o[8 * i + 5] = o[8 * i + 5] * al + p * bf_hi(w.z); o[8 * i + 6] = o[8 * i + 6] * al + p * bf_lo(w.w); o[8 * i + 7] = o[8 * i + 7] * al + p * bf_hi(w.w); }
            }
        }
        gate_store(o, 1.0f / l, Z + (rowbase + t) * DM + h * HD, OG + (rowbase + t) * DM + h * HD);
    }
}
#ifndef SB_EXIT
#define SB_EXIT 0
#endif
__device__ __forceinline__ void sb_simple_phase(Frame& F, const bf16* Q, const bf16* K, const bf16* V, const bf16* Z, bf16* OG) {
    const int gw = F.vcu * NWAVES + F.wave, NGW = F.G * NWAVES; const int vz = vzero();
    for (int it = gw; it < BATCH * NH * (SEQ / 64); it += NGW) {
        const int ch = it & 63, bh = it >> 6, h = bh & 15, b = bh >> 4; const int t = ch * 64 + F.lane; const size_t rowbase = (size_t)b * SEQ;
        float q[64];
        { const v4u* qp = (const v4u*)(Q + (rowbase + t) * DM + h * HD);
#pragma unroll
          for (int i = 0; i < 8; ++i) { const v4u w = qp[i]; q[8 * i] = bf_lo(w.x); q[8 * i + 1] = bf_hi(w.x); q[8 * i + 2] = bf_lo(w.y); q[8 * i + 3] = bf_hi(w.y); q[8 * i + 4] = bf_lo(w.z); q[8 * i + 5] = bf_hi(w.z); q[8 * i + 6] = bf_lo(w.w); q[8 * i + 7] = bf_hi(w.w); } }
        float carry = 1.f, o[64];
#pragma unroll
        for (int d = 0; d < 64; ++d) o[d] = 0.f;
        for (int s = ch * 64 + 62; s >= 0; --s) {
            if (SB_EXIT && s < ch * 64 && __all(carry < 7.8886e-31f)) break;
            const v4u* kr = (const v4u*)(K + (rowbase + s) * DM + h * HD + vz); const v4u* vr = (const v4u*)(V + (rowbase + s) * DM + h * HD + vz);
            float z2 = 0.f;
#pragma unroll
            for (int i = 0; i < 8; ++i) z2 += dot8(kr[i], q + 8 * i);
            const float a = __builtin_amdgcn_exp2f(-fabsf(z2)), r = 1.0f / (1.0f + a); const float beta = z2 > 0.f ? r : a * r, g = z2 > 0.f ? a * r : r;
            const bool valid = s < t; const float w = valid ? beta * carry : 0.f; carry = valid ? carry * g : carry;
#pragma unroll
            for (int i = 0; i < 8; ++i) { const v4u vw = vr[i];
                o[8 * i] += w * bf_lo(vw.x); o[8 * i + 1] += w * bf_hi(vw.x); o[8 * i + 2] += w * bf_lo(vw.y); o[8 * i + 3] += w * bf_hi(vw.y);
                o[8 * i + 4] += w * bf_lo(vw.z); o[8 * i + 5] += w * bf_hi(vw.z); o[8 * i + 6] += w * bf_lo(vw.w); o[8 * i + 7] += w * bf_hi(vw.w); }
        }
        gate_store(o, 1.0f, Z + (rowbase + t) * DM + h * HD, OG + (rowbase + t) * DM + h * HD);
    }
}
__device__ __forceinline__ void final_norm_phase(Frame& F, float* out, const float* ssq, const float* fg) {
    const int gw = F.vcu * NWAVES + F.wave, NGW = F.G * NWAVES; const int vz = vzero();
    for (int m = gw; m < MROWS; m += NGW) {
        const float* sp = ssq + m + vz; const float s = (sp[0] + sp[MROWS]) + (sp[2 * MROWS] + sp[3 * MROWS]); const float rstd = 1.0f / sqrtf(s * (1.0f / DM) + NORM_EPS);
        GAS f32x4* o = (GAS f32x4*)(out + (size_t)m * DM) + F.lane; const GAS f32x4* g4 = (const GAS f32x4*)fg + F.lane;
#pragma unroll
        for (int j = 0; j < 4; ++j) { const f32x4 v = o[64 * j], g = g4[64 * j]; o[64 * j] = v * rstd * g; }
    }
}

struct Args { const float* in[5]; float* out; unsigned char* ws; int ph_lo, ph_hi; };
__global__ void __launch_bounds__(NWAVES * 64, 2) trunk_fwd(Args args) {
    extern __shared__ __attribute__((aligned(16))) unsigned char lds[];
    Frame F;
    F.lds = (LAS unsigned char*)lds; F.MISC = (volatile LAS unsigned*)(F.lds + MISC_OFF);
    F.tid = threadIdx.x; F.lane = F.tid & 63; F.wave = __builtin_amdgcn_readfirstlane(F.tid >> 6);
    F.G = gridDim.x; { const int bx = blockIdx.x; F.vcu = (F.G % 8 == 0) ? (bx % 8) * (F.G / 8) + bx / 8 : bx; }
    unsigned char* ws = args.ws; F.ctl = (gu32*)(ws + WS_CTL);
    const float* x = args.in[0]; const float* norm_g = args.in[1]; const float* w_in = args.in[2]; const float* w_out = args.in[3]; const float* final_g = args.in[4];
    for (int u = F.tid; u < (EPI_OFF - LDSCTL_OFF) / 4; u += NWAVES * 64) ((LAS unsigned*)(F.lds + LDSCTL_OFF))[u] = 0u;
    __syncthreads();
    XcdBarrier bar; bar.bar = (unsigned*)(F.ctl + CW_BAR); bar.x = 0; bar.st = nullptr;
    if (N_LAUNCHES == 1) bar = xcd_barrier_post((unsigned*)(F.ctl + CW_BAR), F.MISC + 8);
#define GRID_BAR() do { if (N_LAUNCHES == 1) xcd_barrier(bar); } while (0)
    const int lo = args.ph_lo, hi = args.ph_hi;
#define IN(k) (lo <= (k) && (k) < hi)
#define BOTH(k) (IN(k) && IN((k) + 1))
    bf16* XB = (bf16*)(ws + WS_XB); bf16* QKVZ = (bf16*)(ws + WS_QKVZ); bf16* OG = (bf16*)(ws + WS_OG);
    const bf16* Qb = QKVZ; const bf16* Kb = QKVZ + TSTRIDE; const bf16* Vb = QKVZ + 2 * TSTRIDE; const bf16* Zb = QKVZ + 3 * TSTRIDE;
    float* rstd0 = (float*)(ws + WS_RSTD0); float* ssq1 = (float*)(ws + WS_SSQ1); float* ssq2 = (float*)(ws + WS_SSQ2); float* kmeanP = (float*)(ws + WS_KMEAN);
    PG8_LAS float* red = (PG8_LAS float*)(F.lds + EPI_OFF);

    if (IN(0)) { p0_prologue(F, x, norm_g, w_in, w_out, ws); if (BOTH(0)) GRID_BAR(); }
    if (IN(1)) {
        pg8::Gemm g{XB, (const bf16*)(ws + WS_WIN), MROWS, NIN, DM}; pg8::StaticOrder S; S.init(MROWS, NIN, F.G, (int)blockIdx.x);
        pg8::EpiQKVZ<0> E{QKVZ, rstd0, nullptr, kmeanP};
        pg8::gemm_phase<pg8::EpiQKVZ<0>, pg8::StaticOrder, true, true>(F.lds + RING_OFF, g, S, E);
        if (BOTH(1)) GRID_BAR();
    }
    if (IN(2)) { moba_simple_phase(F, Qb, Kb, Vb, Zb, kmeanP, OG); if (BOTH(2)) GRID_BAR(); }
    if (IN(3)) {
        pg8::Gemm g{OG, (const bf16*)(ws + WS_WOUT), MROWS, DM, DM}; pg8::StaticOrder S; S.init(MROWS, DM, F.G, (int)blockIdx.x);
        pg8::EpiRes<true> E{x, args.out, XB, ssq1, red};
        pg8::gemm_phase<pg8::EpiRes<true>, pg8::StaticOrder, true, true>(F.lds + RING_OFF, g, S, E);
        if (BOTH(3)) GRID_BAR();
    }
    if (IN(4)) {
        pg8::Gemm g{XB, (const bf16*)(ws + WS_WIN) + (size_t)NIN * DM, MROWS, NIN, DM}; pg8::StaticOrder S; S.init(MROWS, NIN, F.G, (int)blockIdx.x);
        pg8::EpiQKVZ<1> E{QKVZ, nullptr, ssq1, nullptr};
        pg8::gemm_phase<pg8::EpiQKVZ<1>, pg8::StaticOrder, true, true>(F.lds + RING_OFF, g, S, E);
        if (BOTH(4)) GRID_BAR();
    }
    if (IN(5)) { sb_simple_phase(F, Qb, Kb, Vb, Zb, OG); if (BOTH(5)) GRID_BAR(); }
    if (IN(6)) {
        pg8::Gemm g{OG, (const bf16*)(ws + WS_WOUT) + (size_t)DM * DM, MROWS, DM, DM}; pg8::StaticOrder S; S.init(MROWS, DM, F.G, (int)blockIdx.x);
        pg8::EpiRes<false> E{args.out, args.out, nullptr, ssq2, red};
        pg8::gemm_phase<pg8::EpiRes<false>, pg8::StaticOrder, true, true>(F.lds + RING_OFF, g, S, E);
        if (BOTH(6)) GRID_BAR();
    }
    if (IN(7)) final_norm_phase(F, args.out, ssq2, final_g);
#undef IN
#undef BOTH
}

extern "C" void kernel_launch(void* const* d_in, const int* in_sizes, int n_in, void* d_out, int out_size, void* d_ws, size_t ws_size, hipStream_t stream) {
    static int grid = 0;
    if (grid == 0) {
        if (n_in != 5 || in_sizes[0] != MROWS * DM || out_size != MROWS * DM || ws_size < WS_END) { fprintf(stderr, "kernel_launch: unexpected shapes (n_in %d, in0 %d, out %d, ws %zu); nothing launched\n", n_in, n_in > 0 ? in_sizes[0] : -1, out_size, ws_size); grid = -1; return; }
        int dev = 0, cus = 0, per_cu = 0;
        if (hipGetDevice(&dev) != hipSuccess || hipDeviceGetAttribute(&cus, hipDeviceAttributeMultiprocessorCount, dev) != hipSuccess) { fprintf(stderr, "kernel_launch: device query failed\n"); grid = -1; return; }
        if (hipFuncSetAttribute((const void*)trunk_fwd, hipFuncAttributeMaxDynamicSharedMemorySize, LDS_BYTES) != hipSuccess) { fprintf(stderr, "kernel_launch: hipFuncSetAttribute failed\n"); grid = -1; return; }
        if (hipOccupancyMaxActiveBlocksPerMultiprocessor(&per_cu, (const void*)trunk_fwd, NWAVES * 64, LDS_BYTES) != hipSuccess || per_cu < 1) fprintf(stderr, "kernel_launch: note: occupancy query reports %d workgroups per CU\n", per_cu);
        (void)hipGetLastError();
        grid = cus;
    }
    if (grid < 0) return;
    if (hipMemsetAsync((char*)d_ws + WS_CTL, 0, CTL_ZERO_BYTES, stream) != hipSuccess) { fprintf(stderr, "kernel_launch: hipMemsetAsync failed\n"); return; }
    Args a{};
    for (int i = 0; i < 5; ++i) a.in[i] = (const float*)d_in[i];
    a.out = (float*)d_out; a.ws = (unsigned char*)d_ws;
    for (int li = 0; li < N_LAUNCHES; ++li) {
        a.ph_lo = (N_LAUNCHES == 1) ? 0 : li; a.ph_hi = (N_LAUNCHES == 1) ? PER_PHASE : li + 1;
        hipLaunchKernelGGL(trunk_fwd, dim3(grid), dim3(NWAVES * 64), LDS_BYTES, stream, a);
        const hipError_t le = hipPeekAtLastError();
        if (le != hipSuccess) { fprintf(stderr, "kernel_launch: launch %d failed: %s\n", li, hipGetErrorName(le)); break; }
    }
}
```

```cpp
#include <hip/hip_runtime.h>
#include <cstdio>
#include <cstdint>
#include <cmath>

#ifndef MK_N_LAUNCHES
#define MK_N_LAUNCHES 1
#endif
namespace pg8 {
#define PG8_LAS __attribute__((address_space(3)))
typedef unsigned short bf16_t;
typedef short bf16x8 __attribute__((ext_vector_type(8)));
typedef float f32x4 __attribute__((ext_vector_type(4)));
typedef unsigned u32x4 __attribute__((ext_vector_type(4)));
constexpr int BM = 256, BK = 64, HALF = 128, HTB = HALF * BK * 2  , STAGE_BYTES = 8 * HTB, NXCD = 8, WGM = 4;

__host__ __device__ __forceinline__ int lds_byte(int r, int c) { const int st = (r >> 4) * 2 + (c >> 5), rr = r & 15, cc = c & 31, ob = rr * 64 + cc * 2; return st * 1024 + (ob ^ (((ob >> 9) & 1) << 5)); }
__host__ __device__ __forceinline__ void stage_rc(int b, int& R, int& C) { const int st = b / 1024, sb = b % 1024, swz = sb ^ (((sb >> 9) & 1) << 5); R = (st >> 1) * 16 + swz / 64; C = (st & 1) * 32 + (swz % 64) / 2; }
__host__ __device__ __forceinline__ int perm32(int rho) { const int n = rho >> 4, i = rho & 15; return 8 * (i >> 2) + 4 * n + (i & 3); }

struct Unit { int pm, pn; };
struct Gemm { const bf16_t* A; const bf16_t* Bt; int M, N, K; };

struct StaticOrder {
    int nM, nN, nwg, G, c;
    __host__ __device__ void init(int M, int N, int G_, int c_) { nM = M / BM; nN = N / BM; nwg = nM * nN; G = G_; c = c_; }
    __host__ __device__ bool next(int i, Unit& u) const {
        const long L = (long)i * G + c; if (L >= nwg) return false;
        int wgid = (int)L; { const int q = nwg / NXCD, r = nwg % NXCD, xcd = wgid % NXCD, off = wgid / NXCD; wgid = (xcd < r ? xcd * (q + 1) : r * (q + 1) + (xcd - r) * q) + off; }
        const int nig = WGM * nN, gid = wgid / nig, fm = gid * WGM, gsz = (nM - fm) < WGM ? (nM - fm) : WGM;
        u.pm = fm + ((wgid % nig) % gsz); u.pn = (wgid % nig) / gsz; return true;
    }
    __device__ __forceinline__ void a_ready(const Unit&) const {}
    __device__ __forceinline__ void done(const Unit&) const {}
};

}
constexpr int BATCH = 8, SEQ = 4096, DM = 1024, NH = 16, HD = 64, MROWS = BATCH * SEQ, NIN = 4 * DM, DEPTH = 2;
constexpr int MBLK = 256, NBLK = SEQ / MBLK;
constexpr float NORM_EPS = 1e-6f;
constexpr float LOG2E = 1.4426950408889634f;
constexpr float QSCALE = 0.125f * LOG2E;
constexpr size_t TSTRIDE = (size_t)MROWS * DM;

namespace pg8 {
__device__ __forceinline__ unsigned cvt_pk_bf16(float lo, float hi) { unsigned r; asm volatile("v_cvt_pk_bf16_f32 %0, %1, %2" : "=v"(r) : "v"(lo), "v"(hi)); return r; }
typedef unsigned u32x2 __attribute__((ext_vector_type(2)));

template <int LAYER> struct EpiQKVZ {
    static constexpr bool PERM = true, AFTER_DRAIN = false;
    bf16_t* QKVZ; const float* rstd0; const float* ssq; float* kmeanP;
    __device__ __forceinline__ void operator()(const f32x4 (&acc)[2][2][4][2], const Unit& u, int wr, int wc, int fr, int fq, int tid) const {
        const int t = u.pn >> 2, colt = (u.pn & 3) * BM;
        bf16_t* base = QKVZ + (size_t)t * TSTRIDE;
        const float sc = (t == 0) ? QSCALE : 1.f;
        const int row0 = u.pm * BM + wr * 64 + fr, col0 = colt + wc * 32 + 8 * fq;
        const int bb = (u.pm * BM) / SEQ, srow0 = row0 - bb * SEQ, hb0 = bb * NH + ((colt + wc * 32) >> 6), dcol = (wc & 1) * 32 + 8 * fq;
        float rs[2][4];
#pragma unroll
        for (int ai = 0; ai < 2; ++ai)
#pragma unroll
            for (int m = 0; m < 4; ++m) { const int row = row0 + ai * HALF + m * 16;
                if (LAYER == 0) rs[ai][m] = rstd0[row] * sc;
                else { const float s = (ssq[row] + ssq[MROWS + row]) + (ssq[2 * MROWS + row] + ssq[3 * MROWS + row]); rs[ai][m] = (1.0f / sqrtf(s * (1.0f / DM) + NORM_EPS)) * sc; } }
        const bool km = (LAYER == 0) && (t == 1);
        f32x4 cs[2][2];
#pragma unroll
        for (int bj = 0; bj < 2; ++bj)
#pragma unroll
            for (int n = 0; n < 2; ++n) cs[bj][n] = (f32x4){0.f, 0.f, 0.f, 0.f};
#pragma unroll
        for (int ai = 0; ai < 2; ++ai)
#pragma unroll
            for (int m = 0; m < 4; ++m) { bf16_t* rowp = base + ((size_t)hb0 * SEQ + (size_t)(srow0 + ai * HALF + m * 16)) * HD + dcol; const float r = rs[ai][m];
#pragma unroll
                for (int bj = 0; bj < 2; ++bj) { const f32x4 v0 = acc[ai][bj][m][0] * r, v1 = acc[ai][bj][m][1] * r;
                    if (LAYER == 0 && km) { cs[bj][0] += v0; cs[bj][1] += v1; }
                    u32x4 w; w.x = cvt_pk_bf16(v0[0], v0[1]); w.y = cvt_pk_bf16(v0[2], v0[3]); w.z = cvt_pk_bf16(v1[0], v1[1]); w.w = cvt_pk_bf16(v1[2], v1[3]);
                    __builtin_nontemporal_store(w, (u32x4*)(rowp + (size_t)bj * 2 * SEQ * HD)); } }
        if (LAYER == 0) { if (km) {
#pragma unroll
            for (int bj = 0; bj < 2; ++bj)
#pragma unroll
                for (int n = 0; n < 2; ++n)
#pragma unroll
                    for (int e = 0; e < 4; ++e) { float s = cs[bj][n][e]; s += __shfl_xor(s, 1); s += __shfl_xor(s, 2); s += __shfl_xor(s, 4); s += __shfl_xor(s, 8); cs[bj][n][e] = s; }
            if (fr == 0) { float* kp = kmeanP + ((size_t)wr * (BATCH * NBLK) + u.pm) * DM + colt + wc * 32 + 8 * fq;
#pragma unroll
                for (int bj = 0; bj < 2; ++bj) { *(f32x4*)(kp + bj * HALF) = cs[bj][0]; *(f32x4*)(kp + bj * HALF + 4) = cs[bj][1]; } } } }
    }
};

template <int LAYER> struct EpiRes {
    static constexpr bool PERM = false, AFTER_DRAIN = false;
    const float* basef; const bf16_t* baseh; float* outf; bf16_t* outh; float* ssq; PG8_LAS float* red;
    __device__ __forceinline__ void operator()(const f32x4 (&acc)[2][2][4][2], const Unit& u, int wr, int wc, int fr, int fq, int tid) const {
        const int col0 = u.pn * BM + wc * 32 + 4 * fq;
#pragma unroll
        for (int ai = 0; ai < 2; ++ai)
#pragma unroll
            for (int m = 0; m < 4; ++m) { const int r = ai * HALF + wr * 64 + m * 16 + fr; const size_t off = (size_t)(u.pm * BM + r) * DM + col0; float s = 0.f;
#pragma unroll
                for (int bj = 0; bj < 2; ++bj)
#pragma unroll
                    for (int n = 0; n < 2; ++n) { f32x4 bs;
                        if (LAYER == 0) bs = *(const f32x4*)(basef + off + bj * HALF + n * 16);
                        else { const u32x2 w = *(const u32x2*)(baseh + off + bj * HALF + n * 16); bs = (f32x4){__builtin_bit_cast(float, w.x << 16), __builtin_bit_cast(float, w.x & 0xffff0000u), __builtin_bit_cast(float, w.y << 16), __builtin_bit_cast(float, w.y & 0xffff0000u)}; }
                        const f32x4 o = bs + acc[ai][bj][m][n];
                        s += (o[0] * o[0] + o[1] * o[1]) + (o[2] * o[2] + o[3] * o[3]);
                        if (LAYER == 0) { u32x2 w; w.x = cvt_pk_bf16(o[0], o[1]); w.y = cvt_pk_bf16(o[2], o[3]); *(u32x2*)(outh + off + bj * HALF + n * 16) = w; }
                        else *(f32x4*)(outf + off + bj * HALF + n * 16) = o; }
                s += __shfl_xor(s, 16); s += __shfl_xor(s, 32);
                if (fq == 0) red[r * 4 + wc] = s;
                if (m & 1) asm volatile("" ::: "memory"); }
        asm volatile("s_waitcnt lgkmcnt(0)" ::: "memory"); __builtin_amdgcn_s_barrier(); asm volatile("" ::: "memory");
        if (tid < BM) { const PG8_LAS f32x4* p = (const PG8_LAS f32x4*)red + tid; const f32x4 v = *p; ssq[(size_t)u.pn * MROWS + u.pm * BM + tid] = (v[0] + v[1]) + (v[2] + v[3]); }
    }
};
struct EpiFinal {
    static constexpr bool PERM = false, AFTER_DRAIN = false;
    const bf16_t* baseh; float* outf; const float* gain; float* slots; unsigned* cnt; PG8_LAS float* red;
    __device__ __forceinline__ void operator()(f32x4 (&acc)[2][2][4][2], const Unit& u, int wr, int wc, int fr, int fq, int tid) const {
        const int col0 = u.pn * BM + wc * 32 + 4 * fq; const int lane = tid & 63;
#pragma unroll
        for (int ai = 0; ai < 2; ++ai)
#pragma unroll
            for (int m = 0; m < 4; ++m) { const int r = ai * HALF + wr * 64 + m * 16 + fr; const size_t off = (size_t)(u.pm * BM + r) * DM + col0; float s = 0.f;
#pragma unroll
                for (int bj = 0; bj < 2; ++bj)
#pragma unroll
                    for (int n = 0; n < 2; ++n) { const u32x2 w = *(const u32x2*)(baseh + off + bj * HALF + n * 16);
                        const f32x4 bs = (f32x4){__builtin_bit_cast(float, w.x << 16), __builtin_bit_cast(float, w.x & 0xffff0000u), __builtin_bit_cast(float, w.y << 16), __builtin_bit_cast(float, w.y & 0xffff0000u)};
                        const f32x4 o = bs + acc[ai][bj][m][n]; acc[ai][bj][m][n] = o;
                        s += (o[0] * o[0] + o[1] * o[1]) + (o[2] * o[2] + o[3] * o[3]); }
                s += __shfl_xor(s, 16); s += __shfl_xor(s, 32);
                if (fq == 0) red[r * 4 + wc] = s;
                if (m & 1) asm volatile("" ::: "memory"); }
        asm volatile("s_waitcnt lgkmcnt(0)" ::: "memory"); __builtin_amdgcn_s_barrier(); asm volatile("" ::: "memory");
        PG8_LAS unsigned* flag = (PG8_LAS unsigned*)(red + 1024);
        if (tid < BM) { const PG8_LAS f32x4* p = (const PG8_LAS f32x4*)red + tid; const f32x4 v = *p; const float mine = (v[0] + v[1]) + (v[2] + v[3]);
            __hip_atomic_store(slots + (size_t)(u.pm * BM + tid) * 4 + u.pn, mine, __ATOMIC_RELAXED, __HIP_MEMORY_SCOPE_AGENT);
            asm volatile("s_waitcnt vmcnt(0)" ::: "memory");
            if (lane == 0) __hip_atomic_fetch_add(cnt + 64 * u.pm, 1u, __ATOMIC_RELAXED, __HIP_MEMORY_SCOPE_AGENT); }
        if (tid < 64) {
            unsigned spins = 0u;
            for (;;) { if ((unsigned)__builtin_amdgcn_readfirstlane(__hip_atomic_load(cnt + 64 * u.pm, __ATOMIC_RELAXED, __HIP_MEMORY_SCOPE_AGENT)) >= 16u) break;
                if (++spins > (1u << 22)) break; __builtin_amdgcn_s_sleep(2); }
            __builtin_amdgcn_fence(__ATOMIC_ACQUIRE, "agent");
            if (lane == 0) flag[0] = spins; }
        asm volatile("s_waitcnt vmcnt(0) lgkmcnt(0)" ::: "memory"); __builtin_amdgcn_s_barrier(); asm volatile("" ::: "memory");
        if (tid < BM) { const float* sl = slots + (size_t)(u.pm * BM + tid) * 4; float t = 0.f;
#pragma unroll
            for (int k = 0; k < 4; ++k) t += __hip_atomic_load(sl + k, __ATOMIC_RELAXED, __HIP_MEMORY_SCOPE_AGENT);
            red[tid] = 1.0f / sqrtf(t * (1.0f / DM) + NORM_EPS); }
        asm volatile("s_waitcnt lgkmcnt(0)" ::: "memory"); __builtin_amdgcn_s_barrier(); asm volatile("" ::: "memory");
        f32x4 gv[2][2];
#pragma unroll
        for (int bj = 0; bj < 2; ++bj)
#pragma unroll
            for (int n = 0; n < 2; ++n) gv[bj][n] = *(const f32x4*)(gain + col0 + bj * HALF + n * 16);
#pragma unroll
        for (int ai = 0; ai < 2; ++ai)
#pragma unroll
            for (int m = 0; m < 4; ++m) { const int r = ai * HALF + wr * 64 + m * 16 + fr; const float rs = red[r]; const size_t off = (size_t)(u.pm * BM + r) * DM + col0;
#pragma unroll
                for (int bj = 0; bj < 2; ++bj)
#pragma unroll
                    for (int n = 0; n < 2; ++n) *(f32x4*)(outf + off + bj * HALF + n * 16) = acc[ai][bj][m][n] * rs * gv[bj][n]; }
        asm volatile("s_waitcnt lgkmcnt(0)" ::: "memory"); __builtin_amdgcn_s_barrier(); asm volatile("" ::: "memory");
    }
};
}
namespace pg8 {
template <class Epi, class Sched, bool ALIGN_EPI = false, bool SP2 = false>
__device__ __forceinline__ void gemm_phase(PG8_LAS unsigned char* lds, const Gemm g, const Sched& S, const Epi& E) {
    const int tid = threadIdx.x, wid = __builtin_amdgcn_readfirstlane(tid >> 6), lane = tid & 63, wr = wid >> 2, wc = wid & 3, fr = lane & 15, fq = lane >> 4;
    const int K = g.K, nt = K / BK;
    unsigned voffA[2], voffB[2];
#pragma unroll
    for (int i = 0; i < 2; ++i) { int R, C; stage_rc(tid * 16 + i * 8192, R, C); const int Rb = Epi::PERM ? ((R & ~31) + perm32(R & 31)) : R;
        voffA[i] = (unsigned)(R * K + C) * 2u; voffB[i] = (unsigned)(Rb * K + C) * 2u; }
    const size_t kstep = (size_t)(BK * 2);
    const size_t hstep = (size_t)HALF * K * 2;
    const size_t tstep = 2 * hstep;
    const unsigned ldsw = (unsigned)wid * 1024u;
    const int aoff = lds_byte(wr * 64 + fr, fq * 8), boff = lds_byte(wc * 32 + fr, fq * 8);
#define PG8_SA(b, h) (((b) * 2 + (h)) * HTB)
#define PG8_SB(b, h) ((4 + (b) * 2 + (h)) * HTB)
#define PG8_STAGE(bufoff, gbase, voff) do { _Pragma("unroll") for (int _i = 0; _i < 2; ++_i) \
        __builtin_amdgcn_global_load_lds((const unsigned*)((const char*)(gbase) + (voff)[_i]), (PG8_LAS unsigned*)(lds + (bufoff) + ldsw + _i * 8192), 16, 0, 0); } while (0)
#define PG8_LDA(dst, b, h) do { _Pragma("unroll") for (int m = 0; m < 4; ++m) _Pragma("unroll") for (int k = 0; k < 2; ++k) dst[m][k] = *(const PG8_LAS bf16x8*)(lds + PG8_SA(b, h) + aoff + m * 2048 + k * 1024); } while (0)
#define PG8_LDB(dst, b, h) do { _Pragma("unroll") for (int n = 0; n < 2; ++n) _Pragma("unroll") for (int k = 0; k < 2; ++k) dst[n][k] = *(const PG8_LAS bf16x8*)(lds + PG8_SB(b, h) + boff + n * 2048 + k * 1024); } while (0)
#define PG8_MMA(ai, bj, At, Bt) do { __builtin_amdgcn_s_setprio(1); _Pragma("unroll") for (int m = 0; m < 4; ++m) _Pragma("unroll") for (int n = 0; n < 2; ++n) _Pragma("unroll") for (int k = 0; k < 2; ++k) \
        acc[ai][bj][m][n] = __builtin_amdgcn_mfma_f32_16x16x32_bf16(Bt[n][k], At[m][k], acc[ai][bj][m][n], 0, 0, 0); __builtin_amdgcn_s_setprio(0); } while (0)
#define PG8_WAIT_V(n) asm volatile("s_waitcnt vmcnt(" #n ")" ::: "memory")
#define PG8_WAIT_L(n) asm volatile("s_waitcnt lgkmcnt(" #n ")" ::: "memory")
#define PG8_BAR __builtin_amdgcn_s_barrier()
#define PG8_SCHED __builtin_amdgcn_sched_barrier(0)
    Unit cur, nxt; int ui = 0;
    if (!S.next(0, cur)) return;
    f32x4 acc[2][2][4][2];
#pragma unroll
    for (int a = 0; a < 2; ++a)
#pragma unroll
        for (int b = 0; b < 2; ++b)
#pragma unroll
            for (int m = 0; m < 4; ++m)
#pragma unroll
                for (int n = 0; n < 2; ++n) acc[a][b][m][n] = (f32x4){0.f, 0.f, 0.f, 0.f};
    bf16x8 At[4][2], B0[2][2], B1[2][2];
    const char* cA = (const char*)g.A + (size_t)cur.pm * tstep; const char* cB = (const char*)g.Bt + (size_t)cur.pn * tstep;
    S.a_ready(cur);
    if constexpr (SP2) {
        PG8_STAGE(PG8_SB(0, 0), cB, voffB); PG8_STAGE(PG8_SB(0, 1), cB + hstep, voffB); PG8_STAGE(PG8_SA(0, 0), cA, voffA); PG8_STAGE(PG8_SA(0, 1), cA + hstep, voffA);
        if (wr == 1) PG8_BAR;
        PG8_WAIT_V(2); PG8_BAR;
        PG8_STAGE(PG8_SB(1, 0), cB + kstep, voffB); PG8_STAGE(PG8_SA(1, 0), cA + kstep, voffA); PG8_STAGE(PG8_SB(1, 1), cB + hstep + kstep, voffB);
        PG8_WAIT_V(6); PG8_BAR;
    } else {
        PG8_STAGE(PG8_SB(0, 0), cB, voffB); PG8_STAGE(PG8_SA(0, 0), cA, voffA); PG8_STAGE(PG8_SB(0, 1), cB + hstep, voffB); PG8_STAGE(PG8_SA(0, 1), cA + hstep, voffA);
        if (wr == 1) PG8_BAR;
        PG8_WAIT_V(4); PG8_BAR;
        PG8_STAGE(PG8_SB(1, 0), cB + kstep, voffB); PG8_STAGE(PG8_SA(1, 0), cA + kstep, voffA); PG8_STAGE(PG8_SB(1, 1), cB + hstep + kstep, voffB);
        PG8_WAIT_V(6); PG8_BAR;
    }
    for (;;) {
        const bool has_next = S.next(ui + 1, nxt);
        const char* nA = has_next ? (const char*)g.A + (size_t)nxt.pm * tstep : cA; const char* nB = has_next ? (const char*)g.Bt + (size_t)nxt.pn * tstep : cB;
        for (int t = 0; t < nt; t += 2) {
            const bool last = (t == nt - 2);
            const char* a1 = cA + (size_t)(t + 1) * kstep;
            const char* a2 = last ? nA : cA + (size_t)(t + 2) * kstep; const char* b2 = last ? nB : cB + (size_t)(t + 2) * kstep;
            const char* a3 = a2 + kstep; const char* b3 = b2 + kstep;
            if (last && has_next) S.a_ready(nxt);
            if constexpr (SP2) {
            PG8_LDB(B0, 0, 0); PG8_LDB(B1, 0, 1); PG8_SCHED; PG8_LDA(At, 0, 0); PG8_STAGE(PG8_SA(1, 1), a1 + hstep, voffA);
            PG8_WAIT_V(8); PG8_WAIT_L(0); PG8_BAR; PG8_MMA(0, 0, At, B0); PG8_MMA(0, 1, At, B1); PG8_BAR; PG8_SCHED;
            PG8_LDA(At, 0, 1); PG8_STAGE(PG8_SB(0, 0), b2, voffB); PG8_STAGE(PG8_SB(0, 1), b2 + hstep, voffB); PG8_STAGE(PG8_SA(0, 0), a2, voffA);
            PG8_WAIT_V(8); PG8_WAIT_L(0); PG8_BAR; PG8_MMA(1, 0, At, B0); PG8_MMA(1, 1, At, B1); PG8_BAR; PG8_SCHED;
            PG8_LDB(B0, 1, 0); PG8_LDB(B1, 1, 1); PG8_SCHED; PG8_LDA(At, 1, 0); PG8_STAGE(PG8_SA(0, 1), a2 + hstep, voffA);
            PG8_WAIT_V(8); PG8_WAIT_L(0); PG8_BAR; PG8_MMA(0, 0, At, B0); PG8_MMA(0, 1, At, B1); PG8_BAR; PG8_SCHED;
            PG8_LDA(At, 1, 1); PG8_STAGE(PG8_SB(1, 0), b3, voffB); PG8_STAGE(PG8_SB(1, 1), b3 + hstep, voffB); PG8_STAGE(PG8_SA(1, 0), a3, voffA);
            PG8_WAIT_V(8); PG8_WAIT_L(0); PG8_BAR; PG8_MMA(1, 0, At, B0); PG8_MMA(1, 1, At, B1); PG8_BAR; PG8_SCHED;
            } else {
            PG8_LDB(B0, 0, 0); PG8_SCHED; PG8_LDA(At, 0, 0); PG8_STAGE(PG8_SA(1, 1), a1 + hstep, voffA);
            PG8_WAIT_L(8); PG8_BAR; PG8_WAIT_L(0); PG8_MMA(0, 0, At, B0); PG8_BAR; PG8_SCHED;
            PG8_LDB(B1, 0, 1); PG8_STAGE(PG8_SB(0, 0), b2, voffB);
            PG8_BAR; PG8_WAIT_L(0); PG8_MMA(0, 1, At, B1); PG8_BAR;
            PG8_LDA(At, 0, 1); PG8_STAGE(PG8_SA(0, 0), a2, voffA);
            PG8_BAR; PG8_WAIT_L(0); PG8_MMA(1, 0, At, B0); PG8_BAR; PG8_SCHED;
            PG8_STAGE(PG8_SB(0, 1), b2 + hstep, voffB);
            PG8_WAIT_V(6); PG8_BAR; PG8_MMA(1, 1, At, B1); PG8_BAR;
            PG8_LDB(B0, 1, 0); PG8_SCHED; PG8_LDA(At, 1, 0); PG8_STAGE(PG8_SA(0, 1), a2 + hstep, voffA);
            PG8_WAIT_L(8); PG8_BAR; PG8_WAIT_L(0); PG8_MMA(0, 0, At, B0); PG8_BAR; PG8_SCHED;
            PG8_LDB(B1, 1, 1); PG8_STAGE(PG8_SB(1, 0), b3, voffB);
            PG8_BAR; PG8_WAIT_L(0); PG8_MMA(0, 1, At, B1); PG8_BAR;
            PG8_LDA(At, 1, 1); PG8_STAGE(PG8_SA(1, 0), a3, voffA);
            PG8_BAR; PG8_WAIT_L(0); PG8_MMA(1, 0, At, B0); PG8_BAR; PG8_SCHED;
            PG8_STAGE(PG8_SB(1, 1), b3 + hstep, voffB);
            PG8_WAIT_V(6); PG8_BAR; PG8_MMA(1, 1, At, B1); PG8_BAR;
            }
        }
        if constexpr (ALIGN_EPI) { if (wr == 0) PG8_BAR; }
        if constexpr (!Epi::AFTER_DRAIN) { E(acc, cur, wr, wc, fr, fq, tid); S.done(cur); }
        if (!has_next) break;
#pragma unroll
        for (int a = 0; a < 2; ++a)
#pragma unroll
            for (int b = 0; b < 2; ++b)
#pragma unroll
                for (int m = 0; m < 4; ++m)
#pragma unroll
                    for (int n = 0; n < 2; ++n) acc[a][b][m][n] = (f32x4){0.f, 0.f, 0.f, 0.f};
        cur = nxt; cA = nA; cB = nB; ++ui;
        if constexpr (ALIGN_EPI) { if (wr == 1) PG8_BAR; }
    }
    PG8_WAIT_V(0);
    if constexpr (!ALIGN_EPI) { if (wr == 0) PG8_BAR; }
    PG8_BAR;
    static_assert(!Epi::AFTER_DRAIN, "no after-drain epilogues here");
#undef PG8_SA
#undef PG8_SB
#undef PG8_STAGE
#undef PG8_LDA
#undef PG8_LDB
#undef PG8_MMA
#undef PG8_WAIT_V
#undef PG8_WAIT_L
#undef PG8_BAR
#undef PG8_SCHED
}
}
#define GAS __attribute__((address_space(1)))
#define LAS __attribute__((address_space(3)))
typedef unsigned short bf16;
typedef unsigned v4u __attribute__((ext_vector_type(4)));
typedef float f32x4 __attribute__((ext_vector_type(4)));
typedef short bf16x8 __attribute__((ext_vector_type(8)));
typedef GAS unsigned gu32;
typedef GAS unsigned long long gu64;
#define RLX_AGENT __ATOMIC_RELAXED, __HIP_MEMORY_SCOPE_AGENT
#define LDS_WAIT() asm volatile("s_waitcnt lgkmcnt(0)" ::: "memory")
#define VM_WAIT() asm volatile("s_waitcnt vmcnt(0)" ::: "memory")
__device__ __forceinline__ unsigned long long rt() { return __builtin_amdgcn_s_memrealtime(); }
__device__ __forceinline__ unsigned f2bf(float f) { unsigned u = __builtin_bit_cast(unsigned, f); return (u + 0x7fffu + ((u >> 16) & 1u)) >> 16; }
__device__ __forceinline__ unsigned pk2(float lo, float hi) { return f2bf(lo) | (f2bf(hi) << 16); }

#define XB_TMO      128
#define XB_XCNT(j)  (256  + 64 * (j))
#define XB_XSUB(j)  (1280 + 64 * (j))
#define XB_XGEN(j)  (2304 + 64 * (j))
#define XB_TOP      3328
#define XB_TOPGEN   3392
#define XCD_BAR_WORDS 3456
#define XB_SPIN_CAP (1u << 22)

__device__ __forceinline__ unsigned xb_ld(unsigned* p)              { return __hip_atomic_load(p, __ATOMIC_RELAXED, __HIP_MEMORY_SCOPE_AGENT); }
__device__ __forceinline__ unsigned xb_add(unsigned* p, unsigned v) { return __hip_atomic_fetch_add(p, v, __ATOMIC_RELAXED, __HIP_MEMORY_SCOPE_AGENT); }
__device__ __forceinline__ unsigned xb_xcc_id() { return (unsigned)__builtin_amdgcn_s_getreg((3 << 11) | 20) & 0xFu; }
#define XB_SPIN(cond, bar) do { unsigned _sp = 0; while (cond) { __builtin_amdgcn_s_sleep(1); \
    if ((++_sp & 255u) == 0u) { if (xb_ld(&(bar)[XB_TMO])) break; if (_sp > XB_SPIN_CAP) { atomicAdd(&(bar)[XB_TMO], 1u); break; } } } } while (0)

struct XcdBarrier {
    unsigned* bar; unsigned x;
    volatile LAS unsigned* st;
};

__device__ __forceinline__ XcdBarrier xcd_barrier_post(unsigned* bar, volatile LAS unsigned* st) {
    XcdBarrier b; b.bar = bar; b.x = xb_xcc_id(); b.st = st;
    if (threadIdx.x == 0) (void)xb_add(&bar[XB_XCNT(b.x)], 1u);
    return b;
}
__device__ __forceinline__ void xcd_barrier_complete(unsigned* bar, unsigned x, unsigned& nloc, unsigned& nx) {
    const unsigned G = gridDim.x * gridDim.y * gridDim.z;
    unsigned sum, cnt, mine, sp = 0u;
    for (;;) {
        sum = 0u; cnt = 0u; mine = 0u;
#pragma unroll
        for (unsigned j = 0; j < 16; ++j) { const unsigned c = xb_ld(&bar[XB_XCNT(j)]); sum += c; cnt += (c > 0u) ? 1u : 0u; mine = (j == x) ? c : mine; }
        if (sum == G) break;
        __builtin_amdgcn_s_sleep(1);
        if ((++sp & 255u) == 0u) { if (xb_ld(&bar[XB_TMO])) break; if (sp > XB_SPIN_CAP) { atomicAdd(&bar[XB_TMO], 1u); break; } }
    }
    nloc = mine > 0u ? mine : 1u; nx = cnt > 0u ? cnt : 1u;
}

__device__ __forceinline__ void xcd_barrier(const XcdBarrier& b) {
    asm volatile("s_waitcnt vmcnt(0)" ::: "memory");
    __syncthreads();
    if (threadIdx.x == 0) {
        unsigned* bar = b.bar;
        __builtin_amdgcn_s_waitcnt(0);
        unsigned nloc = b.st[0], nx = b.st[1];
        if (nloc == 0u) { xcd_barrier_complete(bar, b.x, nloc, nx); b.st[0] = nloc; b.st[1] = nx; }
        const unsigned old = xb_add(&bar[XB_XSUB(b.x)], 1u);
        const unsigned gen = old / nloc;
        if (old + 1u == (gen + 1u) * nloc) {
            __builtin_amdgcn_fence(__ATOMIC_RELEASE, "agent");
            asm volatile("s_waitcnt vmcnt(0)" ::: "memory");
            const unsigned og = xb_add(&bar[XB_TOP], 1u);
            const unsigned tg = og / nx;
            if (og + 1u == (tg + 1u) * nx) xb_add(&bar[XB_TOPGEN], 1u);
            else XB_SPIN(xb_ld(&bar[XB_TOPGEN]) == tg, bar);
            __builtin_amdgcn_fence(__ATOMIC_ACQUIRE, "agent");
            xb_add(&bar[XB_XGEN(b.x)], 1u);
            asm volatile("s_waitcnt vmcnt(0)" ::: "memory");
        } else {
            XB_SPIN(xb_ld(&bar[XB_XGEN(b.x)]) == gen, bar);
            __builtin_amdgcn_fence(__ATOMIC_ACQUIRE, "agent");
            asm volatile("s_waitcnt vmcnt(0)" ::: "memory");
        }
    }
    __syncthreads();
}

template <class PF> __device__ __forceinline__ void xcd_barrier_pf(const XcdBarrier& b, PF&& prefetch) {
    asm volatile("s_waitcnt vmcnt(0)" ::: "memory");
    __syncthreads();
    if (threadIdx.x >= 64) prefetch();
    if (threadIdx.x == 0) {
        unsigned* bar = b.bar;
        __builtin_amdgcn_s_waitcnt(0);
        unsigned nloc = b.st[0], nx = b.st[1];
        if (nloc == 0u) { xcd_barrier_complete(bar, b.x, nloc, nx); b.st[0] = nloc; b.st[1] = nx; }
        const unsigned old = xb_add(&bar[XB_XSUB(b.x)], 1u);
        const unsigned gen = old / nloc;
        if (old + 1u == (gen + 1u) * nloc) {
            __builtin_amdgcn_fence(__ATOMIC_RELEASE, "agent");
            asm volatile("s_waitcnt vmcnt(0)" ::: "memory");
            const unsigned og = xb_add(&bar[XB_TOP], 1u);
            const unsigned tg = og / nx;
            if (og + 1u == (tg + 1u) * nx) xb_add(&bar[XB_TOPGEN], 1u);
            else XB_SPIN(xb_ld(&bar[XB_TOPGEN]) == tg, bar);
            __builtin_amdgcn_fence(__ATOMIC_ACQUIRE, "agent");
            xb_add(&bar[XB_XGEN(b.x)], 1u);
            asm volatile("s_waitcnt vmcnt(0)" ::: "memory");
        } else {
            XB_SPIN(xb_ld(&bar[XB_XGEN(b.x)]) == gen, bar);
            __builtin_amdgcn_fence(__ATOMIC_ACQUIRE, "agent");
            asm volatile("s_waitcnt vmcnt(0)" ::: "memory");
        }
    }
    __syncthreads();
}

struct GrpBarrier { unsigned* arr; unsigned* gen; unsigned* tmo; unsigned n; unsigned same; };
template <class PF> __device__ __forceinline__ void grp_barrier_pf(const GrpBarrier& gb, PF&& prefetch) {
    asm volatile("s_waitcnt vmcnt(0)" ::: "memory");
    __syncthreads();
    if (threadIdx.x >= 64) prefetch();
    if (threadIdx.x == 0) {
        __builtin_amdgcn_s_waitcnt(0);
        if (!gb.same) { __builtin_amdgcn_fence(__ATOMIC_RELEASE, "agent"); asm volatile("s_waitcnt vmcnt(0)" ::: "memory"); }
        const unsigned old = xb_add(gb.arr, 1u), gen = old / gb.n;
        if (old + 1u == (gen + 1u) * gb.n) xb_add(gb.gen, 1u);
        else XB_SPIN(xb_ld(gb.gen) == gen, gb.tmo);
        __builtin_amdgcn_fence(__ATOMIC_ACQUIRE, "agent");
        asm volatile("s_waitcnt vmcnt(0)" ::: "memory");
    }
    __syncthreads();
}
__device__ __forceinline__ void grp_barrier(const GrpBarrier& gb) { grp_barrier_pf(gb, [] {}); }
namespace moba {
using bf16x8 = __attribute__((ext_vector_type(8))) short;
using s16x4 = __attribute__((ext_vector_type(4))) short;
using f32x16 = __attribute__((ext_vector_type(16))) float;
using u32x4 = __attribute__((ext_vector_type(4))) unsigned;
using f32x4 = __attribute__((ext_vector_type(4))) float;
typedef unsigned short bf16;
constexpr int NW = 8, QBLK = 32, QB = QBLK * NW, KVBLK = 64;
__device__ __forceinline__ int crow(int r, int hi) { return (r & 3) + 8 * (r >> 2) + 4 * hi; }
#define SBAR() __builtin_amdgcn_sched_barrier(0)
__device__ __forceinline__ void cmask(f32x16& p0, f32x16& p1, int jb, int qrel, int hi) {
    const float NEG = -INFINITY; int thr = qrel - 64 * jb - 4 * hi; asm volatile("" : "+v"(thr));
#pragma unroll
    for (int r = 0; r < 16; ++r) { const int c = (r & 3) + 8 * (r >> 2); if (c > thr) p0[r] = NEG; if (c + 32 > thr) p1[r] = NEG; }
}
constexpr int NSLOT = 3, SLOTB = 8192;
constexpr int LDS_K = 0, LDS_V = NSLOT * SLOTB, LDS_WS = 2 * NSLOT * SLOTB, LDS_OST = LDS_WS + NW * 64 * 4, LDS_BYTES = LDS_OST + NW * 8192;
constexpr float NEG_BIG = -1.0e30f;
__device__ __forceinline__ void glds16(const void* gsrc, unsigned lds_dst) { unsigned keep;
    asm volatile("s_mov_b32 %0, m0\n\ts_mov_b32 m0, %2\n\ts_nop 0\n\tglobal_load_lds_dwordx4 %1, off\n\ts_mov_b32 m0, %0" : "=&s"(keep) : "v"(gsrc), "s"(lds_dst) : "memory"); }
__device__ __forceinline__ float max3f(float a, float b, float c) { float r; asm("v_max3_f32 %0, %1, %2, %3" : "=v"(r) : "v"(a), "v"(b), "v"(c)); return r; }
__device__ __forceinline__ float max2f(float a, float b) { float r; asm("v_max_f32_e32 %0, %1, %2" : "=v"(r) : "v"(a), "v"(b)); return r; }
__device__ __forceinline__ float fadd_s(float a, float b) { float r; asm("v_add_f32_e32 %0, %1, %2" : "=v"(r) : "v"(a), "v"(b)); return r; }
__device__ __forceinline__ float fsub_s(float a, float b) { float r; asm("v_sub_f32_e32 %0, %1, %2" : "=v"(r) : "v"(a), "v"(b)); return r; }
typedef float f32x2_t __attribute__((ext_vector_type(2))); typedef __bf16 bf16x2_t __attribute__((ext_vector_type(2)));
__device__ __forceinline__ unsigned cvtpk_s(float lo, float hi) { f32x2_t v = {lo, hi}; bf16x2_t b = __builtin_convertvector(v, bf16x2_t); return __builtin_bit_cast(unsigned, b); }
#define WAIT_BAR(N) asm volatile("s_waitcnt vmcnt(" #N ") lgkmcnt(0)\n\ts_barrier" ::: "memory")
#define MFMA32(a, b, c) __builtin_amdgcn_mfma_f32_32x32x16_bf16(a, b, c, 0, 0, 0)
__device__ __forceinline__ unsigned fbits(float f) { return __builtin_bit_cast(unsigned, f); }
__device__ __forceinline__ float bitsf(unsigned u) { return __builtin_bit_cast(float, u); }
__device__ __forceinline__ float trunc16(float f) { return bitsf(fbits(f) & 0xffff0000u); }

typedef __attribute__((address_space(3))) const char* lds_cptr;
typedef short v4i16_t __attribute__((ext_vector_type(4)));
__device__ __forceinline__ void kload8(bf16x8* kf, lds_cptr kp) {
    kf[0] = *(const __attribute__((address_space(3))) bf16x8*)(kp);        kf[1] = *(const __attribute__((address_space(3))) bf16x8*)(kp + 512);
    kf[2] = *(const __attribute__((address_space(3))) bf16x8*)(kp + 2048); kf[3] = *(const __attribute__((address_space(3))) bf16x8*)(kp + 2560);
    kf[4] = *(const __attribute__((address_space(3))) bf16x8*)(kp + 4096); kf[5] = *(const __attribute__((address_space(3))) bf16x8*)(kp + 4608);
    kf[6] = *(const __attribute__((address_space(3))) bf16x8*)(kp + 6144); kf[7] = *(const __attribute__((address_space(3))) bf16x8*)(kp + 6656);
}
__device__ __forceinline__ void kload2(bf16x8* kf, lds_cptr kp, int j) { kf[2 * j] = *(const __attribute__((address_space(3))) bf16x8*)(kp + j * 2048); kf[2 * j + 1] = *(const __attribute__((address_space(3))) bf16x8*)(kp + j * 2048 + 512); }
__device__ __forceinline__ s16x4 vtr(lds_cptr p) { return __builtin_bit_cast(s16x4, __builtin_amdgcn_ds_read_tr16_b64_v4i16((__attribute__((address_space(3))) v4i16_t*)p)); }
__device__ __forceinline__ float rowmax(const f32x16& p0, const f32x16& p1) {
    float a = max3f(p0[0], p0[1], p1[0]), b = max3f(p0[2], p0[3], p1[1]); a = max3f(a, p1[2], p1[3]);
#pragma unroll
    for (int r = 4; r < 16; r += 4) { a = max3f(a, p0[r], p0[r + 1]); b = max3f(b, p0[r + 2], p0[r + 3]); a = max3f(a, p1[r], p1[r + 1]); b = max3f(b, p1[r + 2], p1[r + 3]); }
    const float m = max2f(a, b);
    auto rr = __builtin_amdgcn_permlane32_swap(__float_as_uint(m), __float_as_uint(m), false, false);
    return max2f(__uint_as_float(rr[0]), __uint_as_float(rr[1]));
}
__device__ __forceinline__ void pv(f32x16* o, int vb, bf16x8 pa0, bf16x8 pa1, bf16x8 pa2, bf16x8 pa3) {
#pragma unroll
    for (int d0 = 0; d0 < 2; ++d0) { s16x4 lo[4], hi[4];
#pragma unroll
        for (int ks = 0; ks < 4; ++ks) {
            asm volatile("ds_read_b64_tr_b16 %0,%1 offset:%c2" : "=&v"(lo[ks]) : "v"(vb), "i"(d0 * 4096 + ks * 1024) : "memory");
            asm volatile("ds_read_b64_tr_b16 %0,%1 offset:%c2" : "=&v"(hi[ks]) : "v"(vb), "i"(d0 * 4096 + ks * 1024 + 512) : "memory"); }
        asm volatile("s_waitcnt lgkmcnt(0)" ::: "memory"); SBAR();
#define PK(k) (bf16x8){lo[k][0], lo[k][1], lo[k][2], lo[k][3], hi[k][0], hi[k][1], hi[k][2], hi[k][3]}
        o[d0] = MFMA32(pa0, PK(0), o[d0]); o[d0] = MFMA32(pa1, PK(1), o[d0]); o[d0] = MFMA32(pa2, PK(2), o[d0]); o[d0] = MFMA32(pa3, PK(3), o[d0]);
#undef PK
    }
}
__device__ __forceinline__ bf16x8 kaug_frag(float kkf) {
    u32x4 w; const unsigned kb = fbits(kkf) >> 16;
    w[0] = kb | (kb << 16); w[1] = kb | 0x3f800000u; w[2] = 0x3f803f80u; w[3] = 0u; return __builtin_bit_cast(bf16x8, w);
}

#undef SBAR
#undef WAIT_BAR
#undef MFMA32
}
namespace mg {
using moba::bf16x8; using moba::s16x4; using moba::f32x16; using moba::u32x4; using moba::f32x4; using moba::bf16; using moba::lds_cptr;
using moba::glds16; using moba::cvtpk_s; using moba::fbits; using moba::bitsf; using moba::trunc16; using moba::kaug_frag; using moba::crow; using moba::cmask;
#define MG_MFMA(a, b, c) __builtin_amdgcn_mfma_f32_32x32x16_bf16(a, b, c, 0, 0, 0)
#define MG_SBAR() __builtin_amdgcn_sched_barrier(0)
#define MG_MX3(a, b, c) __builtin_fmaxf(__builtin_fmaxf((a), (b)), (c))
constexpr int LCAP = 4096;
constexpr int TSL = 16384;
typedef unsigned short u16;
typedef unsigned u32x2 __attribute__((ext_vector_type(2)));

__device__ __forceinline__ void pvT(f32x16* o, int vb, bf16x8 pa0, bf16x8 pa1, bf16x8 pa2, bf16x8 pa3) {
#pragma unroll
    for (int d0 = 0; d0 < 2; ++d0) { s16x4 lo[4], hi[4];
#pragma unroll
        for (int ks = 0; ks < 4; ++ks) {
            asm volatile("ds_read_b64_tr_b16 %0,%1 offset:%c2" : "=&v"(lo[ks]) : "v"(vb), "i"(d0 * 4096 + ks * 1024) : "memory");
            asm volatile("ds_read_b64_tr_b16 %0,%1 offset:%c2" : "=&v"(hi[ks]) : "v"(vb), "i"(d0 * 4096 + ks * 1024 + 512) : "memory"); }
        asm volatile("s_waitcnt lgkmcnt(0)" ::: "memory"); MG_SBAR();
#define PK(k) (bf16x8){lo[k][0], lo[k][1], lo[k][2], lo[k][3], hi[k][0], hi[k][1], hi[k][2], hi[k][3]}
        o[d0] = MG_MFMA(PK(0), pa0, o[d0]); o[d0] = MG_MFMA(PK(1), pa1, o[d0]); o[d0] = MG_MFMA(PK(2), pa2, o[d0]); o[d0] = MG_MFMA(PK(3), pa3, o[d0]);
#undef PK
    }
}
struct QAug { u32x4 w; unsigned sl_l16; };
__device__ __forceinline__ void qaug_init(QAug& a, float slope2, int hi) {
    const float sl_h = trunc16(slope2), sl_m = trunc16(slope2 - sl_h), sl_l = trunc16(slope2 - sl_h - sl_m);
    a.w[0] = hi ? 0u : ((fbits(sl_h) >> 16) | (fbits(sl_m) & 0xffff0000u)); a.w[1] = 0u; a.w[2] = 0u; a.w[3] = 0u; a.sl_l16 = hi ? 0u : (fbits(sl_l) >> 16);
}
__device__ __forceinline__ void qaug_rowterm(QAug& a, float rt, int hi) {
    const float rh = trunc16(rt), rm1 = rt - rh, rmm = trunc16(rm1), rl = rm1 - rmm;
    a.w[1] = hi ? 0u : (a.sl_l16 | (fbits(rh) & 0xffff0000u)); a.w[2] = hi ? 0u : ((fbits(rmm) >> 16) | (fbits(rl) & 0xffff0000u));
}
__device__ __forceinline__ void kfrag_load(bf16x8* kf, lds_cptr kp) {
#pragma unroll
    for (int d0 = 0; d0 < 4; ++d0) { kf[2 * d0] = *(const __attribute__((address_space(3))) bf16x8*)(kp + d0 * 2048); kf[2 * d0 + 1] = *(const __attribute__((address_space(3))) bf16x8*)(kp + d0 * 2048 + 512); }
}
template <int THRL> __device__ __forceinline__ void tile_step(f32x16* o, float& mhat, float& l_reg, QAug& qa, float rowoff, const bf16x8* qr, bf16x8* kf, lds_cptr knext, lds_cptr vp, float kk0, bool first, bool domask, int jb, int qrel, int hi) {
    f32x16 C0, C1;
    { float kkf = kk0; asm volatile("" : "+v"(kkf)); const f32x16 zero = f32x16{};
      C0 = MG_MFMA(kaug_frag(kkf), __builtin_bit_cast(bf16x8, qa.w), zero); C1 = MG_MFMA(kaug_frag(kkf + 32.f), __builtin_bit_cast(bf16x8, qa.w), zero);
#pragma unroll
      for (int d0 = 0; d0 < 4; ++d0) { C0 = MG_MFMA(kf[2 * d0], qr[d0], C0); C1 = MG_MFMA(kf[2 * d0 + 1], qr[d0], C1); } }
    MG_SBAR();
    s16x4 vl[8], vh[8];
#pragma unroll
    for (int i8 = 0; i8 < 8; ++i8) { vl[i8] = moba::vtr(vp + ((i8 >> 2) * 4096 + (i8 & 3) * 1024)); vh[i8] = moba::vtr(vp + ((i8 >> 2) * 4096 + (i8 & 3) * 1024 + 512)); }
    if (knext) kfrag_load(kf, knext);
    MG_SBAR();
    if (domask) cmask(C0, C1, jb, qrel, hi);
    float rm;
    { float a = MG_MX3(C0[0], C0[1], C1[0]), b_ = MG_MX3(C0[2], C0[3], C1[1]); a = MG_MX3(a, C1[2], C1[3]);
#pragma unroll
      for (int r = 4; r < 16; r += 4) { a = MG_MX3(a, C0[r], C0[r + 1]); b_ = MG_MX3(b_, C0[r + 2], C0[r + 3]); a = MG_MX3(a, C1[r], C1[r + 1]); b_ = MG_MX3(b_, C1[r + 2], C1[r + 3]); }
      rm = __builtin_fmaxf(a, b_); auto rr = __builtin_amdgcn_permlane32_swap(__float_as_uint(rm), __float_as_uint(rm), false, false); rm = __builtin_fmaxf(__uint_as_float(rr[0]), __uint_as_float(rr[1])); }
    if (first || __any(rm > (float)THRL)) {
        const float dl = first ? rm : __builtin_fmaxf(rm, 0.f); mhat += dl;
#pragma unroll
        for (int r = 0; r < 16; ++r) { C0[r] -= dl; C1[r] -= dl; }
        qaug_rowterm(qa, rowoff - mhat, hi);
        if (!first) { const float f = __builtin_amdgcn_exp2f(-dl); l_reg *= f;
#pragma unroll
            for (int r = 0; r < 16; ++r) { o[0][r] *= f; o[1][r] *= f; } }
    }
    float sa = 0.f, sb = 0.f;
#pragma unroll
    for (int r = 0; r < 16; ++r) { C0[r] = __builtin_amdgcn_exp2f(C0[r]); C1[r] = __builtin_amdgcn_exp2f(C1[r]); sa += C0[r]; sb += C1[r]; asm volatile("" : "+v"(sa), "+v"(sb)); }
    l_reg += sa + sb;
#define PKW(P, B) cvtpk_s(P[B], P[B + 1])
    const u32x4 pw0 = (u32x4){PKW(C0, 0), PKW(C0, 2), PKW(C0, 4), PKW(C0, 6)}, pw1 = (u32x4){PKW(C0, 8), PKW(C0, 10), PKW(C0, 12), PKW(C0, 14)}, pw2 = (u32x4){PKW(C1, 0), PKW(C1, 2), PKW(C1, 4), PKW(C1, 6)}, pw3 = (u32x4){PKW(C1, 8), PKW(C1, 10), PKW(C1, 12), PKW(C1, 14)};
#undef PKW
#define VFR(i) (bf16x8){vl[i][0], vl[i][1], vl[i][2], vl[i][3], vh[i][0], vh[i][1], vh[i][2], vh[i][3]}
    const bf16x8 pa0 = __builtin_bit_cast(bf16x8, pw0), pa1 = __builtin_bit_cast(bf16x8, pw1), pa2 = __builtin_bit_cast(bf16x8, pw2), pa3 = __builtin_bit_cast(bf16x8, pw3);
    o[0] = MG_MFMA(VFR(0), pa0, o[0]); o[1] = MG_MFMA(VFR(4), pa0, o[1]); o[0] = MG_MFMA(VFR(1), pa1, o[0]); o[1] = MG_MFMA(VFR(5), pa1, o[1]);
    o[0] = MG_MFMA(VFR(2), pa2, o[0]); o[1] = MG_MFMA(VFR(6), pa2, o[1]); o[0] = MG_MFMA(VFR(3), pa3, o[0]); o[1] = MG_MFMA(VFR(7), pa3, o[1]);
#undef VFR
}

__device__ __forceinline__ void mg_select(int vcu, int G, int wave, int lane, const bf16* Q, const float* kmeanP, unsigned* cnt, u16* lists) {
    const int r32 = lane & 31, hi = lane >> 5; const int NGW = G * 8;
    for (int gw = vcu * 8 + wave; gw < BATCH * NH * NBLK; gw += NGW) {
        const int bh = gw >> 4, cur = gw & 15; if (cur == 0) continue;
        const int b = bh >> 4, h = bh & 15;
        bf16x8 kmh[4], kml[4];
#pragma unroll
        for (int d0 = 0; d0 < 4; ++d0) {
            f32x4 a0 = (f32x4){0.f, 0.f, 0.f, 0.f}, a1 = a0;
            if (r32 < cur) { const float* p0 = kmeanP + (size_t)(b * NBLK + r32) * DM + h * HD + 16 * d0 + 8 * hi; const float* p1 = p0 + (size_t)BATCH * NBLK * DM;
                a0 = *(const f32x4*)p0 + *(const f32x4*)p1; a1 = *(const f32x4*)(p0 + 4) + *(const f32x4*)(p1 + 4); }
            u32x4 wh, wl;
#pragma unroll
            for (int e = 0; e < 2; ++e) { const float x0 = a0[2 * e], x1 = a0[2 * e + 1], y0 = a1[2 * e], y1 = a1[2 * e + 1];
                wh[e] = (fbits(x0) >> 16) | (fbits(x1) & 0xffff0000u); wh[2 + e] = (fbits(y0) >> 16) | (fbits(y1) & 0xffff0000u);
                wl[e] = cvtpk_s(x0 - trunc16(x0), x1 - trunc16(x1)); wl[2 + e] = cvtpk_s(y0 - trunc16(y0), y1 - trunc16(y1)); }
            kmh[d0] = __builtin_bit_cast(bf16x8, wh); kml[d0] = __builtin_bit_cast(bf16x8, wl);
        }
        const bf16* Qb0 = Q + ((size_t)bh * SEQ + cur * MBLK + r32) * HD + hi * 8;
        bf16x8 qn[4];
#pragma unroll
        for (int d0 = 0; d0 < 4; ++d0) qn[d0] = *reinterpret_cast<const bf16x8*>(&Qb0[d0 * 16]);
        unsigned sel3[8], mym[8]; unsigned total = 0u;
#pragma unroll
        for (int i = 0; i < 8; ++i) {
            bf16x8 qr[4];
#pragma unroll
            for (int d0 = 0; d0 < 4; ++d0) qr[d0] = qn[d0];
            if (i + 1 < 8) {
#pragma unroll
                for (int d0 = 0; d0 < 4; ++d0) qn[d0] = *reinterpret_cast<const bf16x8*>(&Qb0[(size_t)(i + 1) * 32 * HD + d0 * 16]); }
            f32x16 Gt = f32x16{};
#pragma unroll
            for (int d0 = 0; d0 < 4; ++d0) { Gt = MG_MFMA(kmh[d0], qr[d0], Gt); Gt = MG_MFMA(kml[d0], qr[d0], Gt); }
            float own[8], oth[8];
#pragma unroll
            for (int r = 0; r < 8; ++r) { own[r] = Gt[r]; oth[r] = __shfl_xor(own[r], 32); }
            float v1 = -INFINITY, v2 = -INFINITY, v3 = -INFINITY; int i1 = 15, i2 = 15, i3 = 15;
#pragma unroll
            for (int n = 0; n < 15; ++n) { const int idx = (n & 3) + 4 * (n >> 3); const bool mine = (((n >> 2) & 1) == hi);
                float g = mine ? own[idx] : oth[idx]; g = (n < cur) ? g : -INFINITY;
                const bool c1 = g > v1, c2 = g > v2, c3 = g > v3;
                v3 = c2 ? v2 : (c3 ? g : v3); i3 = c2 ? i2 : (c3 ? n : i3);
                v2 = c1 ? v1 : (c2 ? g : v2); i2 = c1 ? i1 : (c2 ? n : i2);
                v1 = c1 ? g : v1;             i1 = c1 ? n : i1; }
            sel3[i] = (unsigned)i1 | ((unsigned)i2 << 4) | ((unsigned)i3 << 8);
            unsigned mm = 0u;
            for (int n = 0; n < cur; ++n) { const bool m = (hi == 0) && (i1 == n || i2 == n || i3 == n); const unsigned long long mask = __ballot(m); if (lane == n) mm = (unsigned)mask; }
            mym[i] = mm; total += (unsigned)__popc(mm);
        }
        unsigned run = 0u;
        if (lane < cur && total != 0u) run = atomicAdd(cnt + bh * NBLK + lane, total);
        const unsigned below = (1u << r32) - 1u;
#pragma unroll
        for (int i = 0; i < 8; ++i) {
            const int s1 = (int)(sel3[i] & 15u), s2 = (int)((sel3[i] >> 4) & 15u), s3 = (int)((sel3[i] >> 8) & 15u); const int row = cur * MBLK + i * 32 + r32;
            const unsigned b1 = (unsigned)__shfl((int)run, s1), m1 = (unsigned)__shfl((int)mym[i], s1), b2 = (unsigned)__shfl((int)run, s2), m2 = (unsigned)__shfl((int)mym[i], s2), b3 = (unsigned)__shfl((int)run, s3), m3 = (unsigned)__shfl((int)mym[i], s3);
            if (hi == 0) {
                if (s1 != 15) lists[((size_t)(bh * NBLK + s1)) * LCAP + b1 + (unsigned)__popc(m1 & below)] = (u16)(row | (0 << 12));
                if (s2 != 15) lists[((size_t)(bh * NBLK + s2)) * LCAP + b2 + (unsigned)__popc(m2 & below)] = (u16)(row | (1 << 12));
                if (s3 != 15) lists[((size_t)(bh * NBLK + s3)) * LCAP + b3 + (unsigned)__popc(m3 & below)] = (u16)(row | (2 << 12)); }
            run += (unsigned)__popc(mym[i]);
        }
    }
}

template <int THRL> __device__ __forceinline__ void gather_chunk(bf16x8* qr, const bf16x8* qnx, const unsigned* ecur, const unsigned* enx, unsigned e, bool valid, int n, int buf, int bh, float slope2, lds_cptr shm3, unsigned lds0, int lane, int r32, int hi,
                                                                bf16* P0, bf16* P1, bf16* P2, float* ML) {
    const int row = (int)(e & 0xfffu), k = (int)(e >> 12);
    const float rowoff = slope2 * (float)(MBLK * (n - (row >> 8)));
    QAug qa; qaug_init(qa, slope2, hi); qaug_rowterm(qa, rowoff, hi);
    float mhat = 0.f, l_reg = 0.f; f32x16 o[2]; o[0] = f32x16{}; o[1] = f32x16{};
    const lds_cptr kb0 = shm3 + (buf * 4) * TSL + hi * 1024 + r32 * 16;
    const lds_cptr vb0 = shm3 + (buf * 4) * TSL + 8192 + ((lane >> 4) & 1) * 32 + (lane & 3) * 8 + (4 * hi + ((lane & 15) >> 2)) * 64;
    bf16x8 kf[8]; kfrag_load(kf, kb0 + 3 * TSL);
#pragma unroll 1
    for (int jt = 3; jt >= 0; --jt)
        tile_step<THRL>(o, mhat, l_reg, qa, rowoff, qr, kf, (jt > 0) ? kb0 + (jt - 1) * TSL : (lds_cptr)0, vb0 + jt * TSL, (float)(64 * jt + r32), jt == 3, false, 0, 0, hi);
    { auto rr = __builtin_amdgcn_permlane32_swap(__float_as_uint(l_reg), __float_as_uint(l_reg), false, false); l_reg = __uint_as_float(rr[0]) + __uint_as_float(rr[1]); }
    const float inv = __builtin_amdgcn_rcpf(l_reg);
    asm volatile("s_waitcnt vmcnt(0)" ::: "memory");
    if (qnx) {
#pragma unroll
        for (int d0 = 0; d0 < 4; ++d0) qr[d0] = qnx[d0];
        asm volatile("" : "+v"(qr[0]), "+v"(qr[1]), "+v"(qr[2]), "+v"(qr[3]) : "v"(ecur[0]), "v"(ecur[1]), "v"(ecur[2]), "v"(ecur[3]), "v"(ecur[4]), "v"(ecur[5]), "v"(ecur[6]), "v"(ecur[7]),
                     "v"(enx[0]), "v"(enx[1]), "v"(enx[2]), "v"(enx[3]), "v"(enx[4]), "v"(enx[5]), "v"(enx[6]), "v"(enx[7]) : "memory"); }
    if (valid) {
        bf16* Pk = (k == 0) ? P0 : (k == 1) ? P1 : P2;
        const int bhk = (k == 2) ? bh : ((bh >> 4) * 2 * NH + (bh & 15));
        u32x4* dst = (u32x4*)(Pk + (((size_t)bhk * SEQ + row) * 2 + hi) * 32);
#pragma unroll
        for (int d0 = 0; d0 < 2; ++d0)
#pragma unroll
            for (int q4 = 0; q4 < 2; ++q4) { u32x4 w;
#pragma unroll
                for (int e2 = 0; e2 < 4; ++e2) w[e2] = cvtpk_s(o[d0][8 * q4 + 2 * e2] * inv, o[d0][8 * q4 + 2 * e2 + 1] * inv);
                dst[d0 * 2 + q4] = w; }
        if (hi == 0) { float* ml = ML + (((size_t)bh * SEQ + row) * 3 + k) * 2; ml[0] = mhat; ml[1] = l_reg; }
    }
}

__device__ __forceinline__ void mg_gather_prefetch(char* shm, int vcu, int G, const bf16* K, const bf16* V) {
    if (G != 256) return;
    const int tid = threadIdx.x, lane = tid & 63; const int wid = __builtin_amdgcn_readfirstlane(tid >> 6);
    const int bh = vcu >> 1, half = vcu & 1; const long hb = (long)bh * SEQ * HD; const unsigned lds0 = (unsigned)(uintptr_t)shm;
    const bf16* ksrc = K + hb + (long)lane * HD + wid * 8; const bf16* vsrc = V + hb + (long)(16 * (wid & 3) + (lane >> 2)) * HD + (wid >> 2) * 32 + (lane & 3) * 8;
    const int n0 = half ? 3 : 0;
#pragma unroll
    for (int jt = 0; jt < 4; ++jt) { const long off = (long)(n0 * 4 + jt) * 64 * HD; const unsigned d = lds0 + (unsigned)jt * TSL + wid * 1024;
        glds16(ksrc + off, (unsigned)__builtin_amdgcn_readfirstlane(d)); glds16(vsrc + off, (unsigned)__builtin_amdgcn_readfirstlane(d + 8192)); }
}
__device__ __forceinline__ void mg_own_prefetch(char* shm, int vcu, int G, const bf16* K, const bf16* V) {
    if (G != 256) return;
    const int tid = threadIdx.x, lane = tid & 63; const int wid = __builtin_amdgcn_readfirstlane(tid >> 6);
    const int j0_ = vcu & 31, bh = (vcu >> 5) * NH + (j0_ >> 4), cur = j0_ & 15; const unsigned lds0 = (unsigned)(uintptr_t)shm;
    const long koff = (long)lane * HD + wid * 8, voff = (long)(16 * (wid & 3) + (lane >> 2)) * HD + (wid >> 2) * 32 + (lane & 3) * 8;
#pragma unroll
    for (int t = 0; t < 2; ++t) { const long base = ((long)bh * SEQ + (long)(4 * cur + t) * 64) * HD; const unsigned d = lds0 + (unsigned)t * TSL + wid * 1024;
        glds16(K + base + koff, (unsigned)__builtin_amdgcn_readfirstlane(d)); glds16(V + base + voff, (unsigned)__builtin_amdgcn_readfirstlane(d + 8192)); }
}

template <int THRL> __device__ __forceinline__ void mg_gather(char* shm, int vcu, int G, const bf16* Q, const bf16* __restrict__ K, const bf16* __restrict__ V, const unsigned* cnt, const u16* lists,
                                                             bf16* P0, bf16* P1, bf16* P2, float* ML, bool pf = false) {
    if (G != 256) return;
    const int tid = threadIdx.x, lane = tid & 63, r32 = lane & 31, hi = lane >> 5; const int wid = __builtin_amdgcn_readfirstlane(tid >> 6);
    const int bh = vcu >> 1, half = vcu & 1, b = bh >> 4, h = bh & 15; const long rowbase = (long)b * SEQ;
    const long hb = (long)bh * SEQ * HD; const bf16* Kh = K + hb, *Vh = V + hb; const bf16* Qh = Q + hb;
    const unsigned lds0 = (unsigned)(uintptr_t)shm; const lds_cptr shm3 = (lds_cptr)shm;
    const bf16* ksrc = Kh + (long)lane * HD + wid * 8;
    const bf16* vsrc = Vh + (long)(16 * (wid & 3) + (lane >> 2)) * HD + (wid >> 2) * 32 + (lane & 3) * 8;
    const float slope2 = exp2f(-0.5f * (float)(h + 1)) * LOG2E;
#define MG_DMA_BLOCK(n_, buf_) do { _Pragma("unroll") for (int jt_ = 0; jt_ < 4; ++jt_) { const long off_ = (long)((n_) * 4 + jt_) * 64 * HD; const unsigned d_ = lds0 + (unsigned)((buf_) * 4 + jt_) * TSL + wid * 1024; \
        glds16(ksrc + off_, (unsigned)__builtin_amdgcn_readfirstlane(d_)); glds16(vsrc + off_, (unsigned)__builtin_amdgcn_readfirstlane(d_ + 8192)); } } while (0)
    const unsigned long long seq = half ? 0xEDCBA987653ull : 0x4210ull; const int NU = half ? 11 : 4;
#define MG_UNIT(i_) ((int)((seq >> (4 * (i_))) & 15ull))
    if (!pf || wid == 0) MG_DMA_BLOCK(MG_UNIT(0), 0);
    unsigned rows_all = 0u; if (lane < NBLK - 1) rows_all = __hip_atomic_load(cnt + bh * NBLK + lane, __ATOMIC_RELAXED, __HIP_MEMORY_SCOPE_AGENT);
    const int j0 = wid;
    unsigned ecur[8], enx[8]; bf16x8 qnx[4];
#define MG_ENTRIES(dst, n_, rows_) do { const u16* l_ = lists + (size_t)(bh * NBLK + (n_)) * LCAP; _Pragma("unroll") for (int c_ = 0; c_ < 8; ++c_) { unsigned ix_ = (unsigned)(32 * (j0 + 8 * c_) + r32); \
        if (ix_ >= (rows_)) ix_ = (rows_) - 1u; dst[c_] = ((rows_) != 0u) ? (unsigned)l_[ix_] : 0u; } } while (0)
#define MG_QLOAD(e_) do { const bf16* q_ = Qh + (long)((e_) & 0xfffu) * HD + hi * 8; _Pragma("unroll") for (int d0 = 0; d0 < 4; ++d0) qnx[d0] = *reinterpret_cast<const bf16x8*>(&q_[d0 * 16]); } while (0)
    bf16x8 qr[4];
    { const int n0 = MG_UNIT(0); const unsigned r0 = (unsigned)__builtin_amdgcn_readlane((int)rows_all, n0); MG_ENTRIES(ecur, n0, r0); MG_QLOAD(ecur[0]);
#pragma unroll
      for (int d0 = 0; d0 < 4; ++d0) qr[d0] = qnx[d0]; }
    bool did = false;
    for (int ui = 0; ui < NU; ++ui) {
        const int n = MG_UNIT(ui), buf = ui & 1; const bool has_nx = ui + 1 < NU; const int nn = has_nx ? MG_UNIT(ui + 1) : 0;
        if (did) asm volatile("s_waitcnt vmcnt(5) lgkmcnt(0)\n\ts_barrier" ::: "memory"); else asm volatile("s_waitcnt vmcnt(0) lgkmcnt(0)\n\ts_barrier" ::: "memory");
        if (has_nx) MG_DMA_BLOCK(nn, buf ^ 1);
        const unsigned rows = (unsigned)__builtin_amdgcn_readlane((int)rows_all, n), rows_nx = has_nx ? (unsigned)__builtin_amdgcn_readlane((int)rows_all, nn) : 0u;
        const int nchunks = (int)((rows + 31u) >> 5), nch_nx = (int)((rows_nx + 31u) >> 5);
        if (has_nx) { MG_ENTRIES(enx, nn, rows_nx); } else {
#pragma unroll
            for (int c = 0; c < 8; ++c) enx[c] = 0u; }
        did = j0 < nchunks;
        if (!did && j0 < nch_nx) { MG_QLOAD(enx[0]);
#pragma unroll
            for (int d0 = 0; d0 < 4; ++d0) qr[d0] = qnx[d0]; }
#pragma unroll
        for (int c = 0; c < 8; ++c) { const int j = j0 + 8 * c; if (!(j < nchunks)) break; {
            const unsigned e = ecur[c]; const bool valid = (unsigned)(32 * j + r32) < rows;
            if (c + 1 < 8 && j + 8 < nchunks) { MG_QLOAD(ecur[(c + 1) & 7]); } else if (j0 < nch_nx) { MG_QLOAD(enx[0]); }
            gather_chunk<THRL>(qr, qnx, ecur, enx, e, valid, n, buf, bh, slope2, shm3, lds0, lane, r32, hi, P0, P1, P2, ML);
        } }
        for (int j = j0 + 64; j < nchunks; j += 8) {
            unsigned ix = (unsigned)(32 * j + r32); const bool valid = ix < rows; if (!valid) ix = rows - 1u;
            const unsigned e = (unsigned)(lists + (size_t)(bh * NBLK + n) * LCAP)[ix];
            const bf16* q_ = Qh + (long)(e & 0xfffu) * HD + hi * 8; bf16x8 qo[4];
#pragma unroll
            for (int d0 = 0; d0 < 4; ++d0) qo[d0] = *reinterpret_cast<const bf16x8*>(&q_[d0 * 16]);
            gather_chunk<THRL>(qo, (const bf16x8*)0, ecur, enx, e, valid, n, buf, bh, slope2, shm3, lds0, lane, r32, hi, P0, P1, P2, ML);
        }
#pragma unroll
        for (int c = 0; c < 8; ++c) ecur[c] = enx[c];
    }
    asm volatile("s_waitcnt vmcnt(0) lgkmcnt(0)\n\ts_barrier" ::: "memory");
#undef MG_DMA_BLOCK
#undef MG_UNIT
#undef MG_ENTRIES
#undef MG_QLOAD
}

constexpr int OWN_LDS_RING = 3 * TSL, OWN_STG_STRIDE = 68;
template <int THRL> __device__ __forceinline__ void mg_own_unit(int b, int h, int cur, int sigma, bool first_unit, int nb, int nh, int ncur, const bf16* Q, const bf16* __restrict__ K, const bf16* __restrict__ V, const bf16* Z,
                                                               const bf16* P0, const bf16* P1, const bf16* P2, const float* ML, bf16* O, char* shm, bool pf = false) {
    const int tid = threadIdx.x, lane = tid & 63, r32 = lane & 31, hi = lane >> 5; const int wid = __builtin_amdgcn_readfirstlane(tid >> 6);
    const int bh = b * NH + h; const long rowbase = (long)b * SEQ; const int q0 = cur * MBLK;
    const bf16* Qw = Q + ((long)bh * SEQ + q0 + wid * 32) * HD;
    const unsigned lds0 = (unsigned)(uintptr_t)shm; const lds_cptr shm3 = (lds_cptr)shm;
    const long koff = (long)lane * HD + wid * 8, voff = (long)(16 * (wid & 3) + (lane >> 2)) * HD + (wid >> 2) * 32 + (lane & 3) * 8;
#define MG_DMA_TILE(b_, h_, t_, slot_) do { const long base_ = (((long)(b_) * NH + (h_)) * SEQ + (long)(t_) * 64) * HD; const unsigned d_ = lds0 + (unsigned)(slot_) * TSL + wid * 1024; \
        glds16(K + base_ + koff, (unsigned)__builtin_amdgcn_readfirstlane(d_)); glds16(V + base_ + voff, (unsigned)__builtin_amdgcn_readfirstlane(d_ + 8192)); } while (0)
    if (first_unit && (!pf || wid == 0)) { MG_DMA_TILE(b, h, 4 * cur + 0, sigma % 3); MG_DMA_TILE(b, h, 4 * cur + 1, (sigma + 1) % 3); }
    bf16x8 qr[4];
#pragma unroll
    for (int d0 = 0; d0 < 4; ++d0) qr[d0] = *reinterpret_cast<const bf16x8*>(&Qw[(long)r32 * HD + d0 * 16 + hi * 8]);
    const float slope2 = exp2f(-0.5f * (float)(h + 1)) * LOG2E;
    QAug qa; qaug_init(qa, slope2, hi); qaug_rowterm(qa, 0.f, hi);
    float mhat = 0.f, l_reg = 0.f; f32x16 o[2]; o[0] = f32x16{}; o[1] = f32x16{};
    const int qrel = wid * 32 + r32;
    const int np = cur < 3 ? cur : 3; const int row = q0 + wid * 32 + r32;
    float mk[3], lk[3]; u32x4 pp[3][4]; u32x4 zw[4];
#pragma unroll 1
    for (int i = 0; i < 4; ++i) {
        asm volatile("s_waitcnt vmcnt(0) lgkmcnt(0)\n\ts_barrier" ::: "memory");
        if (i + 2 < 4) MG_DMA_TILE(b, h, 4 * cur + i + 2, (sigma + i + 2) % 3);
        if (i == 3 && ncur >= 0) { MG_DMA_TILE(nb, nh, 4 * ncur + 0, (sigma + 1) % 3); MG_DMA_TILE(nb, nh, 4 * ncur + 1, (sigma + 2) % 3); }
        if (i == 0) {
#pragma unroll
            for (int k = 0; k < 3; ++k) { if (k < np) { const float* ml = ML + (((size_t)bh * SEQ + row) * 3 + k) * 2; mk[k] = ml[0]; lk[k] = ml[1];
                    const bf16* Pk = (k == 0) ? P0 : (k == 1) ? P1 : P2; const int bhk = (k == 2) ? bh : ((bh >> 4) * 2 * NH + (bh & 15)); const u32x4* src = (const u32x4*)(Pk + (((size_t)bhk * SEQ + row) * 2 + hi) * 32);
#pragma unroll
                    for (int q = 0; q < 4; ++q) pp[k][q] = src[q]; }
                else { mk[k] = 0.f; lk[k] = 0.f;
#pragma unroll
                    for (int q = 0; q < 4; ++q) pp[k][q] = (u32x4){0u, 0u, 0u, 0u}; } }
        }
        if (64 * i > 32 * wid + 31) continue;
        const int tb = ((sigma + i) % 3) * TSL;
        bf16x8 kf[8]; kfrag_load(kf, shm3 + tb + hi * 1024 + r32 * 16);
        tile_step<THRL>(o, mhat, l_reg, qa, 0.f, qr, kf, (lds_cptr)0, shm3 + tb + 8192 + ((lane >> 4) & 1) * 32 + (lane & 3) * 8 + (4 * hi + ((lane & 15) >> 2)) * 64, (float)(64 * i + r32), i == 0, 64 * i + 63 > 32 * wid, i, qrel, hi);
    }
    { const bf16* Zw = Z + ((long)bh * SEQ + q0 + wid * 32) * HD;
#pragma unroll
      for (int q = 0; q < 4; ++q) zw[q] = *(const u32x4*)(Zw + (long)(q * 8 + (lane >> 3)) * HD + (lane & 7) * 8); }
    { auto rr = __builtin_amdgcn_permlane32_swap(__float_as_uint(l_reg), __float_as_uint(l_reg), false, false); l_reg = __uint_as_float(rr[0]) + __uint_as_float(rr[1]); }
    float M = mhat;
#pragma unroll
    for (int k = 0; k < 3; ++k) if (k < np) M = __builtin_fmaxf(M, mk[k]);
    const float wo = __builtin_amdgcn_exp2f(mhat - M); float den = l_reg * wo;
#pragma unroll
    for (int r = 0; r < 16; ++r) { o[0][r] *= wo; o[1][r] *= wo; }
#pragma unroll
    for (int k = 0; k < 3; ++k) { if (k < np) { const float wk = lk[k] * __builtin_amdgcn_exp2f(mk[k] - M); den += wk;
#pragma unroll
            for (int d0 = 0; d0 < 2; ++d0)
#pragma unroll
                for (int q4 = 0; q4 < 2; ++q4) { const u32x4 w = pp[k][d0 * 2 + q4];
#pragma unroll
                    for (int e2 = 0; e2 < 4; ++e2) { o[d0][8 * q4 + 2 * e2] += wk * bitsf(w[e2] << 16); o[d0][8 * q4 + 2 * e2 + 1] += wk * bitsf(w[e2] & 0xffff0000u); } } } }
    const float inv = __builtin_amdgcn_rcpf(den);
    { float* stg = (float*)(shm + OWN_LDS_RING) + wid * (32 * OWN_STG_STRIDE);
#pragma unroll
      for (int d0 = 0; d0 < 2; ++d0)
#pragma unroll
          for (int m = 0; m < 4; ++m) *(f32x4*)(stg + r32 * OWN_STG_STRIDE + d0 * 32 + m * 8 + 4 * hi) = (f32x4){o[d0][4 * m] * inv, o[d0][4 * m + 1] * inv, o[d0][4 * m + 2] * inv, o[d0][4 * m + 3] * inv};
      asm volatile("s_waitcnt lgkmcnt(0)" ::: "memory");
      int lane_e = lane; asm volatile("" : "+v"(lane_e));
      bf16* Ow = O + (rowbase + q0 + wid * 32) * DM + h * HD;
#pragma unroll
      for (int i = 0; i < 4; ++i) { const int rw = i * 8 + (lane_e >> 3), ch = lane_e & 7;
          const f32x4 x0 = *(const f32x4*)(stg + rw * OWN_STG_STRIDE + ch * 8), x1 = *(const f32x4*)(stg + rw * OWN_STG_STRIDE + ch * 8 + 4);
          float zz[8] = {bitsf(zw[i][0] << 16), bitsf(zw[i][0] & 0xffff0000u), bitsf(zw[i][1] << 16), bitsf(zw[i][1] & 0xffff0000u), bitsf(zw[i][2] << 16), bitsf(zw[i][2] & 0xffff0000u), bitsf(zw[i][3] << 16), bitsf(zw[i][3] & 0xffff0000u)};
          float xs[8] = {x0[0], x0[1], x0[2], x0[3], x1[0], x1[1], x1[2], x1[3]}; float rr_[8];
#pragma unroll
          for (int e = 0; e < 8; ++e) { const float sg = __builtin_amdgcn_rcpf(1.0f + __builtin_amdgcn_exp2f(-LOG2E * zz[e])); rr_[e] = xs[e] * zz[e] * sg; }
          u32x4 ov; ov[0] = cvtpk_s(rr_[0], rr_[1]); ov[1] = cvtpk_s(rr_[2], rr_[3]); ov[2] = cvtpk_s(rr_[4], rr_[5]); ov[3] = cvtpk_s(rr_[6], rr_[7]);
          *(u32x4*)(Ow + (long)rw * DM + ch * 8) = ov; }
      asm volatile("s_waitcnt lgkmcnt(0)" ::: "memory"); }
#undef MG_DMA_TILE
}
template <int THRL> __device__ __forceinline__ void mg_own(char* lds, int vcu, int G, const bf16* Q, const bf16* K, const bf16* V, const bf16* Z, const bf16* P0, const bf16* P1, const bf16* P2, const float* ML, bf16* O, bool pf = false) {
    int sigma = 0; bool first = true;
    if (G != 256) return;
    for (int k = 0; k < 8; ++k) { const int j = (vcu & 31) + 32 * k, bh = (vcu >> 5) * NH + (j >> 4), cur = j & 15; const bool hn = k + 1 < 8; const int jn = j + 32, bhn = (vcu >> 5) * NH + (jn >> 4);
        mg_own_unit<THRL>(bh >> 4, bh & 15, cur, sigma, first, hn ? (bhn >> 4) : 0, hn ? (bhn & 15) : 0, hn ? (jn & 15) : -1, Q, K, V, Z, P0, P1, P2, ML, O, lds, pf);
        sigma = (sigma + 1) % 3; first = false; }
    asm volatile("s_waitcnt vmcnt(0) lgkmcnt(0)\n\ts_barrier" ::: "memory");
}
#undef MG_MFMA
#undef MG_SBAR
#undef MG_MX3
}
namespace sbk {
using moba::bf16x8; using moba::s16x4; using moba::f32x16; using moba::u32x4; using moba::f32x4; using moba::bf16; using moba::lds_cptr;
using moba::glds16; using moba::cvtpk_s; using moba::fbits; using moba::bitsf;
constexpr int NW = 8, QBLK = 32, QB = 256, KVBLK = 64, NSLOT = 6, TSLOT = 16384;
constexpr int LDS_RING = 0, LDS_STG = NSLOT * TSLOT, LDS_FLAG = 131072 + 1024;
#define SB_MFMA(a, b, c) __builtin_amdgcn_mfma_f32_32x32x16_bf16(a, b, c, 0, 0, 0)
#define SB_SBAR() __builtin_amdgcn_sched_barrier(0)
constexpr float CARRY_EXIT = 7.8886090522101181e-31f;

template <bool DIAG> __device__ __forceinline__ void sb_tile(f32x16* o, float& carry, const bf16x8* qr, lds_cptr kp, lds_cptr vp, int rowrel, int hi) {
    f32x16 C0, C1;
    { const f32x16 zero = f32x16{};
#pragma unroll
      for (int d0 = 0; d0 < 4; ++d0) { const bf16x8 b0 = *(const __attribute__((address_space(3))) bf16x8*)(kp + d0 * 2048); const bf16x8 b1 = *(const __attribute__((address_space(3))) bf16x8*)(kp + d0 * 2048 + 512);
          if (d0 == 0) { C0 = SB_MFMA(b0, qr[0], zero); C1 = SB_MFMA(b1, qr[0], zero); } else { C0 = SB_MFMA(b0, qr[d0], C0); C1 = SB_MFMA(b1, qr[d0], C1); } } }
    SB_SBAR();
    s16x4 vl[8], vh[8];
#pragma unroll
    for (int i8 = 0; i8 < 8; ++i8) { vl[i8] = moba::vtr(vp + ((i8 >> 2) * 4096 + (i8 & 3) * 1024)); vh[i8] = moba::vtr(vp + ((i8 >> 2) * 4096 + (i8 & 3) * 1024 + 512)); }
    SB_SBAR();
    float g[2][16];
#pragma unroll
    for (int r = 0; r < 16; ++r) { g[0][r] = __builtin_amdgcn_rcpf(1.0f + __builtin_amdgcn_exp2f(C0[r])); g[1][r] = __builtin_amdgcn_rcpf(1.0f + __builtin_amdgcn_exp2f(C1[r])); }
    if (DIAG) { int thr = rowrel - 4 * hi; asm volatile("" : "+v"(thr));
#pragma unroll
        for (int r = 0; r < 16; ++r) { const int c = (r & 3) + 8 * (r >> 2); if (!(c < thr)) g[0][r] = 1.f; if (!(c + 32 < thr)) g[1][r] = 1.f; } }
    float E1[8], E0[8], Gt[8], Cp[8], Pt[8];
#pragma unroll
    for (int u = 0; u < 8; ++u) { const int h = u >> 2, r0 = 4 * (u & 3);
        E1[u] = g[h][r0 + 3] * g[h][r0 + 2]; E0[u] = E1[u] * g[h][r0 + 1]; Gt[u] = E0[u] * g[h][r0];
        auto rr = __builtin_amdgcn_permlane32_swap(__float_as_uint(Gt[u]), __float_as_uint(Gt[u]), false, false);
        const float x0 = __uint_as_float(rr[0]), x1 = __uint_as_float(rr[1]);
        Cp[u] = x0 * x1; Pt[u] = hi ? 1.0f : x1; }
    float off[8]; { float s = carry;
#pragma unroll
      for (int u = 7; u >= 0; --u) { off[u] = s * Pt[u]; s *= Cp[u]; }
      carry = s; }
    u32x4 pw[4];
#pragma unroll
    for (int u = 0; u < 8; ++u) { const int h = u >> 2, r0 = 4 * (u & 3); const float f = off[u];
        const float F2 = g[h][r0 + 3] * f, F1 = E1[u] * f, F0 = E0[u] * f, Fm = Gt[u] * f;
        const float w3 = f - F2, w2 = F2 - F1, w1 = F1 - F0, w0 = F0 - Fm;
        pw[2 * h + ((u & 3) >> 1)][2 * (u & 1)] = cvtpk_s(w0, w1); pw[2 * h + ((u & 3) >> 1)][2 * (u & 1) + 1] = cvtpk_s(w2, w3); }
#define VFR(i) (bf16x8){vl[i][0], vl[i][1], vl[i][2], vl[i][3], vh[i][0], vh[i][1], vh[i][2], vh[i][3]}
    const bf16x8 pa0 = __builtin_bit_cast(bf16x8, pw[0]), pa1 = __builtin_bit_cast(bf16x8, pw[1]), pa2 = __builtin_bit_cast(bf16x8, pw[2]), pa3 = __builtin_bit_cast(bf16x8, pw[3]);
    o[0] = SB_MFMA(pa0, VFR(0), o[0]); o[1] = SB_MFMA(pa0, VFR(4), o[1]); o[0] = SB_MFMA(pa1, VFR(1), o[0]); o[1] = SB_MFMA(pa1, VFR(5), o[1]);
    o[0] = SB_MFMA(pa2, VFR(2), o[0]); o[1] = SB_MFMA(pa2, VFR(6), o[1]); o[0] = SB_MFMA(pa3, VFR(3), o[0]); o[1] = SB_MFMA(pa3, VFR(7), o[1]);
#undef VFR
}

__device__ __forceinline__ void sb_sweep(int b, int h, int qb_hi, int qb_lo, const bf16* Q, const bf16* __restrict__ K, const bf16* __restrict__ V, const bf16* Z, bf16* O, char* shm) {
    const int tid = threadIdx.x, lane = tid & 63, r32 = lane & 31, hi = lane >> 5; const int wid = __builtin_amdgcn_readfirstlane(tid >> 6);
    const long rowbase = (long)b * SEQ; const int j2 = wid >> 1;
    const long hb = (long)(b * NH + h) * SEQ * HD; const bf16* Kh = K + hb, *Vh = V + hb;
    const unsigned lds0 = (unsigned)(uintptr_t)shm; const lds_cptr shm3 = (lds_cptr)shm;
    const bf16* ksrc = Kh + (long)lane * HD + wid * 8;
    const bf16* vsrc = Vh + (long)(16 * (wid & 3) + (lane >> 2)) * HD + (wid >> 2) * 32 + (lane & 3) * 8;
#define SB_DMA(T_) do { const long off_ = (long)(T_) * KVBLK * HD; const unsigned so_ = lds0 + (unsigned)((T_) % NSLOT) * TSLOT + wid * 1024; \
        glds16(ksrc + off_, (unsigned)__builtin_amdgcn_readfirstlane(so_)); glds16(vsrc + off_, (unsigned)__builtin_amdgcn_readfirstlane(so_ + 8192)); } while (0)
    const lds_cptr kp0 = shm3 + hi * 1024 + r32 * 16;
    const lds_cptr vp0 = shm3 + 8192 + ((lane >> 4) & 1) * 32 + (lane & 3) * 8 + (4 * hi + ((lane & 15) >> 2)) * 64;
    typedef volatile __attribute__((address_space(3))) unsigned* lds_vu32p;
    lds_vu32p flags = (lds_vu32p)(shm3 + LDS_FLAG);
    const int rowrel = 32 * (wid & 1) + r32;
    int next_T = -100;
    bf16x8 qn[4];
    for (int qb = qb_hi; qb >= qb_lo; --qb) {
        const int q0 = qb * QB, T0 = 4 * qb, top = T0 + 3;
        const bf16* Qw = Q + (hb + (long)(q0 + wid * QBLK) * HD);
        bf16x8 qr[4];
        if (qb == qb_hi) {
#pragma unroll
            for (int d0 = 0; d0 < 4; ++d0) qr[d0] = *reinterpret_cast<const bf16x8*>(&Qw[(long)r32 * HD + d0 * 16 + hi * 8]); }
        else {
#pragma unroll
            for (int d0 = 0; d0 < 4; ++d0) qr[d0] = qn[d0]; }
        asm volatile("" : "+v"(qr[0]), "+v"(qr[1]), "+v"(qr[2]), "+v"(qr[3]));
        if (next_T < 0 && qb != qb_hi) next_T = -1;
        if (qb == qb_hi || top > next_T + NSLOT) {
            asm volatile("s_waitcnt vmcnt(0) lgkmcnt(0)\n\ts_barrier" ::: "memory");
            next_T = top; }
        { const int lowt = T0 - 2 > 0 ? T0 - 2 : 0; while (next_T >= lowt) { SB_DMA(next_T); --next_T; } }
        float carry = 1.f; f32x16 o[2]; o[0] = f32x16{}; o[1] = f32x16{};
        bool walking = true;
        u32x4 zq[4];
        for (int i = 0;; ++i) {
            { const int L = T0 - i > 0 ? T0 - i : 0; const int k = L - 1 - next_T;
              const bool rel = (i == 2) || (i == 3);
              if (k >= 2) { asm volatile("s_waitcnt vmcnt(4) lgkmcnt(0)\n\ts_barrier" ::: "memory"); }
              else if (k == 1) { if (rel) asm volatile("s_waitcnt vmcnt(10) lgkmcnt(0)\n\ts_barrier" ::: "memory"); else asm volatile("s_waitcnt vmcnt(2) lgkmcnt(0)\n\ts_barrier" ::: "memory"); }
              else { if (rel) asm volatile("s_waitcnt vmcnt(8) lgkmcnt(0)\n\ts_barrier" ::: "memory"); else asm volatile("s_waitcnt vmcnt(0) lgkmcnt(0)\n\ts_barrier" ::: "memory"); } }
            if (i > 1) { lds_vu32p fl = flags + 8 * ((i - 1) & 1); unsigned any = 0u;
#pragma unroll
                for (int w_ = 0; w_ < 8; ++w_) any |= fl[w_];
                if (any == 0u) break; }
            { const int tg = T0 - i - 2; if (tg >= 0 && next_T >= tg) { SB_DMA(next_T); --next_T; } }
            if (i == 1) { const bf16* Zw = Z + (hb + (long)(q0 + wid * QBLK) * HD);
#pragma unroll
                for (int q = 0; q < 4; ++q) zq[q] = *(const u32x4*)(Zw + (long)((q & 1) * 16 + (lane >> 2)) * HD + (q >> 1) * 32 + (lane & 3) * 8);
                { const int back = (qb > qb_lo) ? QB : 0;
#pragma unroll
                  for (int d0 = 0; d0 < 4; ++d0) qn[d0] = *reinterpret_cast<const bf16x8*>(&Qw[(long)(r32 - back) * HD + d0 * 16 + hi * 8]); } }
            const int T = T0 + j2 - i;
            if (walking && T >= 0) {
                const int so = (T % NSLOT) * TSLOT;
                if (i == 0) sb_tile<true>(o, carry, qr, kp0 + so, vp0 + so, rowrel, hi); else sb_tile<false>(o, carry, qr, kp0 + so, vp0 + so, rowrel, hi);
                if (__all(carry < CARRY_EXIT)) walking = false;
            }
            if (lane == 0) flags[8 * (i & 1) + wid] = (walking && (T - 1 >= 0)) ? 1u : 0u;
        }
        { float* stg = (float*)(shm + LDS_STG) + wid * 1024;
          int lane_e = lane; asm volatile("" : "+v"(lane_e));
          bf16* Ow = O + (rowbase + q0 + wid * QBLK) * DM + h * HD;
#pragma unroll
          for (int d0 = 0; d0 < 2; ++d0) {
#pragma unroll
              for (int r = 0; r < 16; ++r) stg[moba::crow(r, hi) * 32 + r32] = o[d0][r];
              asm volatile("s_waitcnt lgkmcnt(0)" ::: "memory");
#pragma unroll
              for (int i2 = 0; i2 < 2; ++i2) { const int row = i2 * 16 + (lane_e >> 2), ch = lane_e & 3;
                  const f32x4 x0 = *(const f32x4*)(stg + row * 32 + ch * 8), x1 = *(const f32x4*)(stg + row * 32 + ch * 8 + 4);
                  const u32x4 zv = zq[2 * d0 + i2];
                  float zz[8] = {bitsf(zv[0] << 16), bitsf(zv[0] & 0xffff0000u), bitsf(zv[1] << 16), bitsf(zv[1] & 0xffff0000u), bitsf(zv[2] << 16), bitsf(zv[2] & 0xffff0000u), bitsf(zv[3] << 16), bitsf(zv[3] & 0xffff0000u)};
                  float xs[8] = {x0[0], x0[1], x0[2], x0[3], x1[0], x1[1], x1[2], x1[3]}; float rr_[8];
#pragma unroll
                  for (int e = 0; e < 8; ++e) { const float sg = __builtin_amdgcn_rcpf(1.0f + __builtin_amdgcn_exp2f(-LOG2E * zz[e])); rr_[e] = xs[e] * zz[e] * sg; }
                  u32x4 ov; ov[0] = cvtpk_s(rr_[0], rr_[1]); ov[1] = cvtpk_s(rr_[2], rr_[3]); ov[2] = cvtpk_s(rr_[4], rr_[5]); ov[3] = cvtpk_s(rr_[6], rr_[7]);
                  *(u32x4*)(Ow + (long)row * DM + d0 * 32 + ch * 8) = ov; }
              asm volatile("s_waitcnt lgkmcnt(0)" ::: "memory"); }
        }
    }
    asm volatile("s_waitcnt vmcnt(0) lgkmcnt(0)\n\ts_barrier" ::: "memory");
#undef SB_DMA
}
__device__ __forceinline__ void sb_phase(char* lds, int vcu, int G, const bf16* Q, const bf16* K, const bf16* V, const bf16* Z, bf16* O) {
    if (G == 256) { const int bh = vcu >> 1, half = vcu & 1; sb_sweep(bh >> 4, bh & 15, half ? 7 : 15, half ? 0 : 8, Q, K, V, Z, O, lds); }
    else { for (int u = vcu; u < BATCH * NH * 2; u += G) { const int bh = u >> 1, half = u & 1; sb_sweep(bh >> 4, bh & 15, half ? 7 : 15, half ? 0 : 8, Q, K, V, Z, O, lds); } }
}
#undef SB_MFMA
#undef SB_SBAR
}
constexpr int NWAVES = 8;
constexpr int N_LAUNCHES = MK_N_LAUNCHES;
constexpr int PER_PHASE = 7;
constexpr size_t MiB = 1u << 20;
constexpr size_t WS_CTL = 0, CTL_ZERO_BYTES = 144 * 1024;
constexpr size_t WS_WIN = 2 * MiB;
constexpr size_t WS_WOUT = 18 * MiB;
constexpr size_t WS_RSTD0 = 22 * MiB;
constexpr size_t WS_SSQ1 = WS_RSTD0 + 512 * 1024;
constexpr size_t WS_SSQ2 = WS_SSQ1 + 512 * 1024;
constexpr size_t WS_KMEAN = 24 * MiB;
constexpr size_t WS_XB = 32 * MiB;
constexpr size_t WS_QKVZ = 96 * MiB;
constexpr size_t WS_OG = 352 * MiB;
constexpr size_t WS_ML = 416 * MiB;
constexpr size_t WS_LISTS = 432 * MiB;
constexpr size_t WS_END = 448 * MiB;
constexpr int CW_SEAM = 16384;
static_assert((32768 + BATCH * NH * NBLK) * 4 <= 144 * 1024, "control words inside the per-call memset");
constexpr int CW_LCNT = 32768;
constexpr int CW_GRP = 8192;
constexpr int CW_BAR = 4096;

constexpr int RING_OFF = 0, RING_BYTES = 131072;
constexpr int LDSCTL_OFF = RING_BYTES, MISC_OFF = LDSCTL_OFF + 320;
constexpr int EPI_OFF = RING_BYTES + 1024;
constexpr int LDS_BYTES = 147456;
static_assert(EPI_OFF + 4096 + 256 <= LDS_BYTES && MISC_OFF + 128 <= EPI_OFF, "LDS map");

struct Frame {
    LAS unsigned char* lds;
    volatile LAS unsigned* MISC;
    gu32* ctl;
    int tid, lane, wave, vcu, G, grp;
};

__device__ __forceinline__ int vzero() { int z; asm volatile("v_mov_b32 %0, 0" : "=v"(z)); return z; }
__device__ __forceinline__ float bf_lo(unsigned u) { return __builtin_bit_cast(float, u << 16); }
__device__ __forceinline__ float bf_hi(unsigned u) { return __builtin_bit_cast(float, u & 0xffff0000u); }
__device__ __forceinline__ float wave_sum(float v) {
#pragma unroll
    for (int o = 1; o < 64; o <<= 1) v += __shfl_xor(v, o);
    return v;
}

__device__ __forceinline__ void p0_transpose_item(const float* W, const float* g, int K, int N, bf16* WT, LAS float* scr, int item, int lane) {
    const int nblk = N / 32, kb = item / nblk, nb = item % nblk, k0 = 64 * kb, n0 = 32 * nb;
#pragma unroll 8
    for (int i = 0; i < 32; ++i) { const int kk = 2 * i + (lane >> 5); const float sc = g ? g[k0 + kk] : 1.f; scr[kk * 33 + (lane & 31)] = W[(size_t)(k0 + kk) * N + n0 + (lane & 31)] * sc; }
    LDS_WAIT(); asm volatile("" ::: "memory");
    const int c = lane & 7;
#pragma unroll
    for (int j = 0; j < 4; ++j) { const int n = (lane >> 3) + 8 * j; const LAS float* s = scr + (8 * c) * 33 + n;
        v4u o; o.x = pk2(s[0 * 33], s[1 * 33]); o.y = pk2(s[2 * 33], s[3 * 33]); o.z = pk2(s[4 * 33], s[5 * 33]); o.w = pk2(s[6 * 33], s[7 * 33]);
        *(GAS v4u*)(WT + (size_t)(n0 + n) * K + k0 + 8 * c) = o; }
    LDS_WAIT(); asm volatile("" ::: "memory");
}
__device__ __forceinline__ void p0_prologue(Frame& F, const float* x, const float* norm_g, const float* w_in, const float* w_out, unsigned char* ws) {
    LAS float* scr = (LAS float*)(F.lds + RING_OFF + F.wave * 16384);
    const int gw = F.vcu * NWAVES + F.wave, NGW = F.G * NWAVES;
    constexpr int I_IN = (DM / 64) * (NIN / 32), I_OUT = (DM / 64) * (DM / 32);
    constexpr int NITEMS = DEPTH * (I_IN + I_OUT);
    for (int it = gw; it < NITEMS; it += NGW) {
        int r = it; const int l = r / (I_IN + I_OUT); r -= l * (I_IN + I_OUT);
        if (r < I_IN) p0_transpose_item(w_in + (size_t)l * DM * NIN, norm_g + l * DM, DM, NIN, (bf16*)(ws + WS_WIN) + (size_t)l * NIN * DM, scr, r, F.lane);
        else p0_transpose_item(w_out + (size_t)l * DM * DM, nullptr, DM, DM, (bf16*)(ws + WS_WOUT) + (size_t)l * DM * DM, scr, r - I_IN, F.lane);
    }
    bf16* XB = (bf16*)(ws + WS_XB); float* rstd0 = (float*)(ws + WS_RSTD0);
    for (int m = gw; m < MROWS; m += NGW) {
        const GAS f32x4* xr = (const GAS f32x4*)(x + (size_t)m * DM) + F.lane; f32x4 v[4]; float s = 0.f;
#pragma unroll
        for (int j = 0; j < 4; ++j) { v[j] = xr[64 * j]; s += (v[j].x * v[j].x + v[j].y * v[j].y) + (v[j].z * v[j].z + v[j].w * v[j].w); }
        s = wave_sum(s);
        if (F.lane == 0) rstd0[m] = 1.0f / sqrtf(s * (1.0f / DM) + NORM_EPS);
        GAS unsigned long long* o8 = (GAS unsigned long long*)(XB + (size_t)m * DM) + F.lane;
#pragma unroll
        for (int j = 0; j < 4; ++j) o8[64 * j] = (unsigned long long)pk2(v[j].x, v[j].y) | ((unsigned long long)pk2(v[j].z, v[j].w) << 32);
    }
}

#ifndef MG_PROBE
#define MG_PROBE 0
#endif
#ifndef REPEAT_PHASE
#define REPEAT_PHASE -1
#endif
#define REPS(k) for (int rep_ = 0; rep_ < ((REPEAT_PHASE == (k)) ? 2 : 1); ++rep_)
#ifndef GEMM_DESYNC_TICKS
#define GEMM_DESYNC_TICKS 0
#endif
__device__ __forceinline__ void desync_delay(int ticks) {
    if (ticks > 0 && (blockIdx.x & 1)) { const unsigned long long t0 = __builtin_amdgcn_s_memrealtime(); while (__builtin_amdgcn_s_memrealtime() - t0 < (unsigned long long)ticks) __builtin_amdgcn_s_sleep(8); }
}
struct Args { const float* in[5]; float* out; unsigned char* ws; int ph_lo, ph_hi; };
__global__ void __launch_bounds__(NWAVES * 64, 2) trunk_fwd(Args args) {
    extern __shared__ __attribute__((aligned(16))) unsigned char lds[];
    Frame F;
    F.lds = (LAS unsigned char*)lds; F.MISC = (volatile LAS unsigned*)(F.lds + MISC_OFF);
    F.tid = threadIdx.x; F.lane = F.tid & 63; F.wave = __builtin_amdgcn_readfirstlane(F.tid >> 6);
    F.G = gridDim.x; { const int bx = blockIdx.x; F.vcu = (F.G % 8 == 0) ? (bx % 8) * (F.G / 8) + bx / 8 : bx; }
    unsigned char* ws = args.ws; F.ctl = (gu32*)(ws + WS_CTL);
    const float* x = args.in[0]; const float* norm_g = args.in[1]; const float* w_in = args.in[2]; const float* w_out = args.in[3]; const float* final_g = args.in[4];
    for (int u = F.tid; u < (EPI_OFF - LDSCTL_OFF) / 4; u += NWAVES * 64) ((LAS unsigned*)(F.lds + LDSCTL_OFF))[u] = 0u;
    __syncthreads();
    { const unsigned simd = (unsigned)__builtin_amdgcn_s_getreg((1 << 11) | (4 << 6) | 4) & 3u;
      if (F.lane == 0) F.MISC[16 + F.wave] = simd;
      __syncthreads();
      int rank = 0;
      for (int w = 0; w < NWAVES; ++w) { const unsigned sw = F.MISC[16 + w]; if (w < F.wave && sw == simd) ++rank; }
      F.grp = __builtin_amdgcn_readfirstlane(rank & 1); }
    XcdBarrier bar; bar.bar = (unsigned*)(F.ctl + CW_BAR); bar.x = 0; bar.st = nullptr;
    if (N_LAUNCHES == 1) bar = xcd_barrier_post((unsigned*)(F.ctl + CW_BAR), F.MISC + 8);
#define GRID_BAR() do { if (N_LAUNCHES == 1) xcd_barrier(bar); } while (0)
    const bool use_grp = (N_LAUNCHES == 1) && (F.G == 256);
    GrpBarrier gbar; { const unsigned g_ = blockIdx.x & 7u; gbar.arr = (unsigned*)(F.ctl + CW_GRP + 64 * g_); gbar.gen = (unsigned*)(F.ctl + CW_GRP + 512 + 64 * g_); gbar.tmo = (unsigned*)(F.ctl + CW_BAR); gbar.n = 32u; gbar.same = 0u; }
    if (use_grp && F.tid == 0) ((unsigned*)(F.ctl + CW_GRP + 1024))[blockIdx.x] = xb_xcc_id() + 1u;
#define GRP_BAR() do { if (use_grp) grp_barrier(gbar); else GRID_BAR(); } while (0)
    const int lo = args.ph_lo, hi = args.ph_hi;
#define IN(k) (lo <= (k) && (k) < hi)
#define BOTH(k) (IN(k) && IN((k) + 1))
    bf16* XB = (bf16*)(ws + WS_XB); bf16* QKVZ = (bf16*)(ws + WS_QKVZ); bf16* OG = (bf16*)(ws + WS_OG);
    const bf16* Qb = QKVZ; const bf16* Kb = QKVZ + TSTRIDE; const bf16* Vb = QKVZ + 2 * TSTRIDE; const bf16* Zb = QKVZ + 3 * TSTRIDE;
    float* rstd0 = (float*)(ws + WS_RSTD0); float* ssq1 = (float*)(ws + WS_SSQ1); float* ssq2 = (float*)(ws + WS_SSQ2); float* kmeanP = (float*)(ws + WS_KMEAN);
    PG8_LAS float* red = (PG8_LAS float*)(F.lds + EPI_OFF);

    if (IN(0)) REPS(0) { p0_prologue(F, x, norm_g, w_in, w_out, ws); if (BOTH(0)) GRID_BAR(); }
    if (use_grp && BOTH(0)) {
        if (F.tid == 0) { const unsigned* xt = (const unsigned*)(F.ctl + CW_GRP + 1024); const unsigned mine = xb_ld((unsigned*)xt + blockIdx.x); unsigned ok = (mine != 0u) ? 1u : 0u;
            for (int k_ = 0; k_ < 32; ++k_) ok &= (xb_ld((unsigned*)xt + (blockIdx.x & 7u) + 8u * k_) == mine) ? 1u : 0u;
            F.MISC[12] = ok; }
        __syncthreads(); gbar.same = F.MISC[12]; }
    if (IN(1)) REPS(1) { desync_delay(GEMM_DESYNC_TICKS);
        pg8::Gemm g{XB, (const bf16*)(ws + WS_WIN), MROWS, NIN, DM}; pg8::StaticOrder S; S.init(MROWS, NIN, F.G, (int)blockIdx.x);
        pg8::EpiQKVZ<0> E{QKVZ, rstd0, nullptr, kmeanP};
        pg8::gemm_phase<pg8::EpiQKVZ<0>, pg8::StaticOrder, true, true>(F.lds + RING_OFF, g, S, E);
        if (BOTH(1)) GRP_BAR();
    }
    if (IN(2)) {
        bf16* PP0 = (bf16*)args.out; bf16* PP1 = (bf16*)args.out + (size_t)NH * SEQ * HD; bf16* PP2 = XB;
        float* ML = (float*)(ws + WS_ML); mg::u16* lists = (mg::u16*)(ws + WS_LISTS); unsigned* lcnt = (unsigned*)(F.ctl + CW_LCNT);
        mg::mg_select(F.vcu, F.G, F.wave, F.lane, Qb, kmeanP, lcnt, lists);
        const bool pfc = (N_LAUNCHES == 1) && (F.G == 256);
        if (pfc) grp_barrier_pf(gbar, [&] { mg::mg_gather_prefetch((char*)lds + RING_OFF, F.vcu, F.G, Kb, Vb); }); else GRID_BAR();
        for (int rp_ = 0; rp_ < ((MG_PROBE == 1) ? 2 : 1); ++rp_) mg::mg_gather<8>((char*)lds + RING_OFF, F.vcu, F.G, Qb, Kb, Vb, lcnt, lists, PP0, PP1, PP2, ML, pfc);
        if (pfc) grp_barrier_pf(gbar, [&] { mg::mg_own_prefetch((char*)lds + RING_OFF, F.vcu, F.G, Kb, Vb); }); else GRID_BAR();
        for (int rp_ = 0; rp_ < ((MG_PROBE == 2) ? 2 : 1); ++rp_) mg::mg_own<8>((char*)lds + RING_OFF, F.vcu, F.G, Qb, Kb, Vb, Zb, PP0, PP1, PP2, ML, OG, pfc);
        if (BOTH(2)) GRP_BAR();
    }
    if (IN(3)) REPS(3) { desync_delay(GEMM_DESYNC_TICKS);
        pg8::Gemm g{OG, (const bf16*)(ws + WS_WOUT), MROWS, DM, DM}; pg8::StaticOrder S; S.init(MROWS, DM, F.G, (int)blockIdx.x);
        pg8::EpiRes<0> E{x, nullptr, nullptr, XB, ssq1, red};
        pg8::gemm_phase<pg8::EpiRes<0>, pg8::StaticOrder, true, true>(F.lds + RING_OFF, g, S, E);
        if (BOTH(3)) GRP_BAR();
    }
    if (IN(4)) REPS(4) { desync_delay(GEMM_DESYNC_TICKS);
        pg8::Gemm g{XB, (const bf16*)(ws + WS_WIN) + (size_t)NIN * DM, MROWS, NIN, DM}; pg8::StaticOrder S; S.init(MROWS, NIN, F.G, (int)blockIdx.x);
        pg8::EpiQKVZ<1> E{QKVZ, nullptr, ssq1, nullptr};
        pg8::gemm_phase<pg8::EpiQKVZ<1>, pg8::StaticOrder, true, true>(F.lds + RING_OFF, g, S, E);
        if (BOTH(4)) GRP_BAR();
    }
    if (IN(5)) REPS(5) { sbk::sb_phase((char*)lds + RING_OFF, F.vcu, F.G, Qb, Kb, Vb, Zb, OG); if (BOTH(5)) GRP_BAR(); }
    if (IN(6)) { desync_delay(GEMM_DESYNC_TICKS);
        pg8::Gemm g{OG, (const bf16*)(ws + WS_WOUT) + (size_t)DM * DM, MROWS, DM, DM}; pg8::StaticOrder S; S.init(MROWS, DM, F.G, (int)blockIdx.x);
        pg8::EpiFinal E{XB, args.out, final_g, ssq2, (unsigned*)(F.ctl + CW_SEAM), red};
        pg8::gemm_phase<pg8::EpiFinal, pg8::StaticOrder, true, true>(F.lds + RING_OFF, g, S, E);
    }
#undef IN
#undef BOTH
}

extern "C" void kernel_launch(void* const* d_in, const int* in_sizes, int n_in, void* d_out, int out_size, void* d_ws, size_t ws_size, hipStream_t stream) {
    static int grid = 0;
    if (grid == 0) {
        if (n_in != 5 || in_sizes[0] != MROWS * DM || out_size != MROWS * DM || ws_size < WS_END) { fprintf(stderr, "kernel_launch: unexpected shapes (n_in %d, in0 %d, out %d, ws %zu); nothing launched\n", n_in, n_in > 0 ? in_sizes[0] : -1, out_size, ws_size); grid = -1; return; }
        int dev = 0, cus = 0, per_cu = 0;
        if (hipGetDevice(&dev) != hipSuccess || hipDeviceGetAttribute(&cus, hipDeviceAttributeMultiprocessorCount, dev) != hipSuccess) { fprintf(stderr, "kernel_launch: device query failed\n"); grid = -1; return; }
        if (hipFuncSetAttribute((const void*)trunk_fwd, hipFuncAttributeMaxDynamicSharedMemorySize, LDS_BYTES) != hipSuccess) { fprintf(stderr, "kernel_launch: hipFuncSetAttribute failed\n"); grid = -1; return; }
        if (hipOccupancyMaxActiveBlocksPerMultiprocessor(&per_cu, (const void*)trunk_fwd, NWAVES * 64, LDS_BYTES) != hipSuccess || per_cu < 1) fprintf(stderr, "kernel_launch: note: occupancy query reports %d workgroups per CU\n", per_cu);
        (void)hipGetLastError();
        grid = cus;
    }
    if (grid < 0) return;
    if (hipMemsetAsync((char*)d_ws + WS_CTL, 0, CTL_ZERO_BYTES, stream) != hipSuccess) { fprintf(stderr, "kernel_launch: hipMemsetAsync failed\n"); return; }
    Args a{};
    for (int i = 0; i < 5; ++i) a.in[i] = (const float*)d_in[i];
    a.out = (float*)d_out; a.ws = (unsigned char*)d_ws;
    for (int li = 0; li < N_LAUNCHES; ++li) {
        a.ph_lo = (N_LAUNCHES == 1) ? 0 : li; a.ph_hi = (N_LAUNCHES == 1) ? PER_PHASE : li + 1;
        hipLaunchKernelGGL(trunk_fwd, dim3(grid), dim3(NWAVES * 64), LDS_BYTES, stream, a);
        const hipError_t le = hipPeekAtLastError();
        if (le != hipSuccess) { fprintf(stderr, "kernel_launch: launch %d failed: %s\n", li, hipGetErrorName(le)); break; }
    }
}
```

```cpp
#include <hip/hip_runtime.h>
#include <cstdio>
#include <cstdint>
#include <cmath>

#ifndef MK_N_LAUNCHES
#define MK_N_LAUNCHES 1
#endif
namespace pg8 {
#define PG8_LAS __attribute__((address_space(3)))
typedef unsigned short bf16_t;
typedef short bf16x8 __attribute__((ext_vector_type(8)));
typedef float f32x4 __attribute__((ext_vector_type(4)));
typedef unsigned u32x4 __attribute__((ext_vector_type(4)));
constexpr int BM = 256, BK = 64, HALF = 128, HTB = HALF * BK * 2  , STAGE_BYTES = 8 * HTB, NXCD = 8, WGM = 4;

__host__ __device__ __forceinline__ int lds_byte(int r, int c) { const int st = (r >> 4) * 2 + (c >> 5), rr = r & 15, cc = c & 31, ob = rr * 64 + cc * 2; return st * 1024 + (ob ^ (((ob >> 9) & 1) << 5)); }
__host__ __device__ __forceinline__ void stage_rc(int b, int& R, int& C) { const int st = b / 1024, sb = b % 1024, swz = sb ^ (((sb >> 9) & 1) << 5); R = (st >> 1) * 16 + swz / 64; C = (st & 1) * 32 + (swz % 64) / 2; }
__host__ __device__ __forceinline__ int perm32(int rho) { const int n = rho >> 4, i = rho & 15; return 8 * (i >> 2) + 4 * n + (i & 3); }

struct Unit { int pm, pn; };
struct Gemm { const bf16_t* A; const bf16_t* Bt; int M, N, K; };

struct StaticOrder {
    int nM, nN, nwg, G, c;
    __host__ __device__ void init(int M, int N, int G_, int c_) { nM = M / BM; nN = N / BM; nwg = nM * nN; G = G_; c = c_; }
    __host__ __device__ bool next(int i, Unit& u) const {
        const long L = (long)i * G + c; if (L >= nwg) return false;
        int wgid = (int)L; { const int q = nwg / NXCD, r = nwg % NXCD, xcd = wgid % NXCD, off = wgid / NXCD; wgid = (xcd < r ? xcd * (q + 1) : r * (q + 1) + (xcd - r) * q) + off; }
        const int nig = WGM * nN, gid = wgid / nig, fm = gid * WGM, gsz = (nM - fm) < WGM ? (nM - fm) : WGM;
        u.pm = fm + ((wgid % nig) % gsz); u.pn = (wgid % nig) / gsz; return true;
    }
    __device__ __forceinline__ void a_ready(const Unit&) const {}
    __device__ __forceinline__ void done(const Unit&) const {}
};

}
constexpr int BATCH = 8, SEQ = 4096, DM = 1024, NH = 16, HD = 64, MROWS = BATCH * SEQ, NIN = 4 * DM, DEPTH = 2;
constexpr int MBLK = 256, NBLK = SEQ / MBLK;
constexpr float NORM_EPS = 1e-6f;
constexpr float LOG2E = 1.4426950408889634f;
constexpr float QSCALE = 0.125f * LOG2E;
constexpr size_t TSTRIDE = (size_t)MROWS * DM;

namespace pg8 {
__device__ __forceinline__ unsigned cvt_pk_bf16(float lo, float hi) { unsigned r; asm volatile("v_cvt_pk_bf16_f32 %0, %1, %2" : "=v"(r) : "v"(lo), "v"(hi)); return r; }
typedef unsigned u32x2 __attribute__((ext_vector_type(2)));

template <int LAYER> struct EpiQKVZ {
    static constexpr bool PERM = true, AFTER_DRAIN = false;
    bf16_t* QKVZ; const float* rstd0; const float* ssq; float* kmeanP;
    __device__ __forceinline__ void operator()(const f32x4 (&acc)[2][2][4][2], const Unit& u, int wr, int wc, int fr, int fq, int tid) const {
        const int t = u.pn >> 2, colt = (u.pn & 3) * BM;
        bf16_t* base = QKVZ + (size_t)t * TSTRIDE;
        const float sc = (t == 0) ? QSCALE : 1.f;
        const int row0 = u.pm * BM + wr * 64 + fr, col0 = colt + wc * 32 + 8 * fq;
        const int bb = (u.pm * BM) / SEQ, srow0 = row0 - bb * SEQ, hb0 = bb * NH + ((colt + wc * 32) >> 6), dcol = (wc & 1) * 32 + 8 * fq;
        float rs[2][4];
#pragma unroll
        for (int ai = 0; ai < 2; ++ai)
#pragma unroll
            for (int m = 0; m < 4; ++m) { const int row = row0 + ai * HALF + m * 16;
                if (LAYER == 0) rs[ai][m] = rstd0[row] * sc;
                else { const float s = (ssq[row] + ssq[MROWS + row]) + (ssq[2 * MROWS + row] + ssq[3 * MROWS + row]); rs[ai][m] = (1.0f / sqrtf(s * (1.0f / DM) + NORM_EPS)) * sc; } }
        const bool km = (LAYER == 0) && (t == 1);
        f32x4 cs[2][2];
#pragma unroll
        for (int bj = 0; bj < 2; ++bj)
#pragma unroll
            for (int n = 0; n < 2; ++n) cs[bj][n] = (f32x4){0.f, 0.f, 0.f, 0.f};
#pragma unroll
        for (int ai = 0; ai < 2; ++ai)
#pragma unroll
            for (int m = 0; m < 4; ++m) { bf16_t* rowp = base + ((size_t)hb0 * SEQ + (size_t)(srow0 + ai * HALF + m * 16)) * HD + dcol; const float r = rs[ai][m];
#pragma unroll
                for (int bj = 0; bj < 2; ++bj) { const f32x4 v0 = acc[ai][bj][m][0] * r, v1 = acc[ai][bj][m][1] * r;
                    if (LAYER == 0 && km) { cs[bj][0] += v0; cs[bj][1] += v1; }
                    u32x4 w; w.x = cvt_pk_bf16(v0[0], v0[1]); w.y = cvt_pk_bf16(v0[2], v0[3]); w.z = cvt_pk_bf16(v1[0], v1[1]); w.w = cvt_pk_bf16(v1[2], v1[3]);
                    __builtin_nontemporal_store(w, (u32x4*)(rowp + (size_t)bj * 2 * SEQ * HD)); } }
        if (LAYER == 0) { if (km) {
#pragma unroll
            for (int bj = 0; bj < 2; ++bj)
#pragma unroll
                for (int n = 0; n < 2; ++n)
#pragma unroll
                    for (int e = 0; e < 4; ++e) { float s = cs[bj][n][e]; s += __shfl_xor(s, 1); s += __shfl_xor(s, 2); s += __shfl_xor(s, 4); s += __shfl_xor(s, 8); cs[bj][n][e] = s; }
            if (fr == 0) { float* kp = kmeanP + ((size_t)wr * (BATCH * NBLK) + u.pm) * DM + colt + wc * 32 + 8 * fq;
#pragma unroll
                for (int bj = 0; bj < 2; ++bj) { *(f32x4*)(kp + bj * HALF) = cs[bj][0]; *(f32x4*)(kp + bj * HALF + 4) = cs[bj][1]; } } } }
    }
};

template <int LAYER> struct EpiRes {
    static constexpr bool PERM = false, AFTER_DRAIN = false;
    const float* basef; const bf16_t* baseh; float* outf; bf16_t* outh; float* ssq; PG8_LAS float* red;
    __device__ __forceinline__ void operator()(const f32x4 (&acc)[2][2][4][2], const Unit& u, int wr, int wc, int fr, int fq, int tid) const {
        const int col0 = u.pn * BM + wc * 32 + 4 * fq;
#pragma unroll
        for (int ai = 0; ai < 2; ++ai)
#pragma unroll
            for (int m = 0; m < 4; ++m) { const int r = ai * HALF + wr * 64 + m * 16 + fr; const size_t off = (size_t)(u.pm * BM + r) * DM + col0; float s = 0.f;
#pragma unroll
                for (int bj = 0; bj < 2; ++bj)
#pragma unroll
                    for (int n = 0; n < 2; ++n) { f32x4 bs;
                        if (LAYER == 0) bs = *(const f32x4*)(basef + off + bj * HALF + n * 16);
                        else { const u32x2 w = *(const u32x2*)(baseh + off + bj * HALF + n * 16); bs = (f32x4){__builtin_bit_cast(float, w.x << 16), __builtin_bit_cast(float, w.x & 0xffff0000u), __builtin_bit_cast(float, w.y << 16), __builtin_bit_cast(float, w.y & 0xffff0000u)}; }
                        const f32x4 o = bs + acc[ai][bj][m][n];
                        s += (o[0] * o[0] + o[1] * o[1]) + (o[2] * o[2] + o[3] * o[3]);
                        if (LAYER == 0) { u32x2 w; w.x = cvt_pk_bf16(o[0], o[1]); w.y = cvt_pk_bf16(o[2], o[3]); *(u32x2*)(outh + off + bj * HALF + n * 16) = w; }
                        else *(f32x4*)(outf + off + bj * HALF + n * 16) = o; }
                s += __shfl_xor(s, 16); s += __shfl_xor(s, 32);
                if (fq == 0) red[r * 4 + wc] = s;
                if (m & 1) asm volatile("" ::: "memory"); }
        asm volatile("s_waitcnt lgkmcnt(0)" ::: "memory"); __builtin_amdgcn_s_barrier(); asm volatile("" ::: "memory");
        if (tid < BM) { const PG8_LAS f32x4* p = (const PG8_LAS f32x4*)red + tid; const f32x4 v = *p; ssq[(size_t)u.pn * MROWS + u.pm * BM + tid] = (v[0] + v[1]) + (v[2] + v[3]); }
    }
};
struct EpiFinal {
    static constexpr bool PERM = false, AFTER_DRAIN = false;
    const bf16_t* baseh; float* outf; const float* gain; float* slots; unsigned* cnt; PG8_LAS float* red;
    __device__ __forceinline__ void operator()(f32x4 (&acc)[2][2][4][2], const Unit& u, int wr, int wc, int fr, int fq, int tid) const {
        const int col0 = u.pn * BM + wc * 32 + 4 * fq; const int lane = tid & 63;
#pragma unroll
        for (int ai = 0; ai < 2; ++ai)
#pragma unroll
            for (int m = 0; m < 4; ++m) { const int r = ai * HALF + wr * 64 + m * 16 + fr; const size_t off = (size_t)(u.pm * BM + r) * DM + col0; float s = 0.f;
#pragma unroll
                for (int bj = 0; bj < 2; ++bj)
#pragma unroll
                    for (int n = 0; n < 2; ++n) { const u32x2 w = *(const u32x2*)(baseh + off + bj * HALF + n * 16);
                        const f32x4 bs = (f32x4){__builtin_bit_cast(float, w.x << 16), __builtin_bit_cast(float, w.x & 0xffff0000u), __builtin_bit_cast(float, w.y << 16), __builtin_bit_cast(float, w.y & 0xffff0000u)};
                        const f32x4 o = bs + acc[ai][bj][m][n]; acc[ai][bj][m][n] = o;
                        s += (o[0] * o[0] + o[1] * o[1]) + (o[2] * o[2] + o[3] * o[3]); }
                s += __shfl_xor(s, 16); s += __shfl_xor(s, 32);
                if (fq == 0) red[r * 4 + wc] = s;
                if (m & 1) asm volatile("" ::: "memory"); }
        asm volatile("s_waitcnt lgkmcnt(0)" ::: "memory"); __builtin_amdgcn_s_barrier(); asm volatile("" ::: "memory");
        PG8_LAS unsigned* flag = (PG8_LAS unsigned*)(red + 1024);
        if (tid < BM) { const PG8_LAS f32x4* p = (const PG8_LAS f32x4*)red + tid; const f32x4 v = *p; const float mine = (v[0] + v[1]) + (v[2] + v[3]);
            __hip_atomic_store(slots + (size_t)(u.pm * BM + tid) * 4 + u.pn, mine, __ATOMIC_RELAXED, __HIP_MEMORY_SCOPE_AGENT);
            asm volatile("s_waitcnt vmcnt(0)" ::: "memory");
            if (lane == 0) __hip_atomic_fetch_add(cnt + 64 * u.pm, 1u, __ATOMIC_RELAXED, __HIP_MEMORY_SCOPE_AGENT); }
        if (tid < 64) {
            unsigned spins = 0u;
            for (;;) { if ((unsigned)__builtin_amdgcn_readfirstlane(__hip_atomic_load(cnt + 64 * u.pm, __ATOMIC_RELAXED, __HIP_MEMORY_SCOPE_AGENT)) >= 16u) break;
                if (++spins > (1u << 22)) break; __builtin_amdgcn_s_sleep(2); }
            __builtin_amdgcn_fence(__ATOMIC_ACQUIRE, "agent");
            if (lane == 0) flag[0] = spins; }
        asm volatile("s_waitcnt vmcnt(0) lgkmcnt(0)" ::: "memory"); __builtin_amdgcn_s_barrier(); asm volatile("" ::: "memory");
        if (tid < BM) { const float* sl = slots + (size_t)(u.pm * BM + tid) * 4; float t = 0.f;
#pragma unroll
            for (int k = 0; k < 4; ++k) t += __hip_atomic_load(sl + k, __ATOMIC_RELAXED, __HIP_MEMORY_SCOPE_AGENT);
            red[tid] = 1.0f / sqrtf(t * (1.0f / DM) + NORM_EPS); }
        asm volatile("s_waitcnt lgkmcnt(0)" ::: "memory"); __builtin_amdgcn_s_barrier(); asm volatile("" ::: "memory");
        f32x4 gv[2][2];
#pragma unroll
        for (int bj = 0; bj < 2; ++bj)
#pragma unroll
            for (int n = 0; n < 2; ++n) gv[bj][n] = *(const f32x4*)(gain + col0 + bj * HALF + n * 16);
#pragma unroll
        for (int ai = 0; ai < 2; ++ai)
#pragma unroll
            for (int m = 0; m < 4; ++m) { const int r = ai * HALF + wr * 64 + m * 16 + fr; const float rs = red[r]; const size_t off = (size_t)(u.pm * BM + r) * DM + col0;
#pragma unroll
                for (int bj = 0; bj < 2; ++bj)
#pragma unroll
                    for (int n = 0; n < 2; ++n) *(f32x4*)(outf + off + bj * HALF + n * 16) = acc[ai][bj][m][n] * rs * gv[bj][n]; }
        asm volatile("s_waitcnt lgkmcnt(0)" ::: "memory"); __builtin_amdgcn_s_barrier(); asm volatile("" ::: "memory");
    }
};
}
namespace pg8 {
template <class Epi, class Sched, bool ALIGN_EPI = false, bool SP2 = false>
__device__ __forceinline__ void gemm_phase(PG8_LAS unsigned char* lds, const Gemm g, const Sched& S, const Epi& E) {
    const int tid = threadIdx.x, wid = __builtin_amdgcn_readfirstlane(tid >> 6), lane = tid & 63, wr = wid >> 2, wc = wid & 3, fr = lane & 15, fq = lane >> 4;
    const int K = g.K, nt = K / BK;
    unsigned voffA[2], voffB[2];
#pragma unroll
    for (int i = 0; i < 2; ++i) { int R, C; stage_rc(tid * 16 + i * 8192, R, C); const int Rb = Epi::PERM ? ((R & ~31) + perm32(R & 31)) : R;
        voffA[i] = (unsigned)(R * K + C) * 2u; voffB[i] = (unsigned)(Rb * K + C) * 2u; }
    const size_t kstep = (size_t)(BK * 2);
    const size_t hstep = (size_t)HALF * K * 2;
    const size_t tstep = 2 * hstep;
    const unsigned ldsw = (unsigned)wid * 1024u;
    const int aoff = lds_byte(wr * 64 + fr, fq * 8), boff = lds_byte(wc * 32 + fr, fq * 8);
#define PG8_SA(b, h) (((b) * 2 + (h)) * HTB)
#define PG8_SB(b, h) ((4 + (b) * 2 + (h)) * HTB)
#define PG8_STAGE(bufoff, gbase, voff) do { _Pragma("unroll") for (int _i = 0; _i < 2; ++_i) \
        __builtin_amdgcn_global_load_lds((const unsigned*)((const char*)(gbase) + (voff)[_i]), (PG8_LAS unsigned*)(lds + (bufoff) + ldsw + _i * 8192), 16, 0, 0); } while (0)
#define PG8_LDA(dst, b, h) do { _Pragma("unroll") for (int m = 0; m < 4; ++m) _Pragma("unroll") for (int k = 0; k < 2; ++k) dst[m][k] = *(const PG8_LAS bf16x8*)(lds + PG8_SA(b, h) + aoff + m * 2048 + k * 1024); } while (0)
#define PG8_LDB(dst, b, h) do { _Pragma("unroll") for (int n = 0; n < 2; ++n) _Pragma("unroll") for (int k = 0; k < 2; ++k) dst[n][k] = *(const PG8_LAS bf16x8*)(lds + PG8_SB(b, h) + boff + n * 2048 + k * 1024); } while (0)
#define PG8_MMA(ai, bj, At, Bt) do { __builtin_amdgcn_s_setprio(1); _Pragma("unroll") for (int m = 0; m < 4; ++m) _Pragma("unroll") for (int n = 0; n < 2; ++n) _Pragma("unroll") for (int k = 0; k < 2; ++k) \
        acc[ai][bj][m][n] = __builtin_amdgcn_mfma_f32_16x16x32_bf16(Bt[n][k], At[m][k], acc[ai][bj][m][n], 0, 0, 0); __builtin_amdgcn_s_setprio(0); } while (0)
#define PG8_WAIT_V(n) asm volatile("s_waitcnt vmcnt(" #n ")" ::: "memory")
#define PG8_WAIT_L(n) asm volatile("s_waitcnt lgkmcnt(" #n ")" ::: "memory")
#define PG8_BAR __builtin_amdgcn_s_barrier()
#define PG8_SCHED __builtin_amdgcn_sched_barrier(0)
    Unit cur, nxt; int ui = 0;
    if (!S.next(0, cur)) return;
    f32x4 acc[2][2][4][2];
#pragma unroll
    for (int a = 0; a < 2; ++a)
#pragma unroll
        for (int b = 0; b < 2; ++b)
#pragma unroll
            for (int m = 0; m < 4; ++m)
#pragma unroll
                for (int n = 0; n < 2; ++n) acc[a][b][m][n] = (f32x4){0.f, 0.f, 0.f, 0.f};
    bf16x8 At[4][2], B0[2][2], B1[2][2];
    const char* cA = (const char*)g.A + (size_t)cur.pm * tstep; const char* cB = (const char*)g.Bt + (size_t)cur.pn * tstep;
    S.a_ready(cur);
    if constexpr (SP2) {
        PG8_STAGE(PG8_SB(0, 0), cB, voffB); PG8_STAGE(PG8_SB(0, 1), cB + hstep, voffB); PG8_STAGE(PG8_SA(0, 0), cA, voffA); PG8_STAGE(PG8_SA(0, 1), cA + hstep, voffA);
        if (wr == 1) PG8_BAR;
        PG8_WAIT_V(2); PG8_BAR;
        PG8_STAGE(PG8_SB(1, 0), cB + kstep, voffB); PG8_STAGE(PG8_SA(1, 0), cA + kstep, voffA); PG8_STAGE(PG8_SB(1, 1), cB + hstep + kstep, voffB);
        PG8_WAIT_V(6); PG8_BAR;
    } else {
        PG8_STAGE(PG8_SB(0, 0), cB, voffB); PG8_STAGE(PG8_SA(0, 0), cA, voffA); PG8_STAGE(PG8_SB(0, 1), cB + hstep, voffB); PG8_STAGE(PG8_SA(0, 1), cA + hstep, voffA);
        if (wr == 1) PG8_BAR;
        PG8_WAIT_V(4); PG8_BAR;
        PG8_STAGE(PG8_SB(1, 0), cB + kstep, voffB); PG8_STAGE(PG8_SA(1, 0), cA + kstep, voffA); PG8_STAGE(PG8_SB(1, 1), cB + hstep + kstep, voffB);
        PG8_WAIT_V(6); PG8_BAR;
    }
    for (;;) {
        const bool has_next = S.next(ui + 1, nxt);
        const char* nA = has_next ? (const char*)g.A + (size_t)nxt.pm * tstep : cA; const char* nB = has_next ? (const char*)g.Bt + (size_t)nxt.pn * tstep : cB;
        for (int t = 0; t < nt; t += 2) {
            const bool last = (t == nt - 2);
            const char* a1 = cA + (size_t)(t + 1) * kstep;
            const char* a2 = last ? nA : cA + (size_t)(t + 2) * kstep; const char* b2 = last ? nB : cB + (size_t)(t + 2) * kstep;
            const char* a3 = a2 + kstep; const char* b3 = b2 + kstep;
            if (last && has_next) S.a_ready(nxt);
            if constexpr (SP2) {
            PG8_LDB(B0, 0, 0); PG8_LDB(B1, 0, 1); PG8_SCHED; PG8_LDA(At, 0, 0); PG8_STAGE(PG8_SA(1, 1), a1 + hstep, voffA);
            PG8_WAIT_V(8); PG8_WAIT_L(0); PG8_BAR; PG8_MMA(0, 0, At, B0); PG8_MMA(0, 1, At, B1); PG8_BAR; PG8_SCHED;
            PG8_LDA(At, 0, 1); PG8_STAGE(PG8_SB(0, 0), b2, voffB); PG8_STAGE(PG8_SB(0, 1), b2 + hstep, voffB); PG8_STAGE(PG8_SA(0, 0), a2, voffA);
            PG8_WAIT_V(8); PG8_WAIT_L(0); PG8_BAR; PG8_MMA(1, 0, At, B0); PG8_MMA(1, 1, At, B1); PG8_BAR; PG8_SCHED;
            PG8_LDB(B0, 1, 0); PG8_LDB(B1, 1, 1); PG8_SCHED; PG8_LDA(At, 1, 0); PG8_STAGE(PG8_SA(0, 1), a2 + hstep, voffA);
            PG8_WAIT_V(8); PG8_WAIT_L(0); PG8_BAR; PG8_MMA(0, 0, At, B0); PG8_MMA(0, 1, At, B1); PG8_BAR; PG8_SCHED;
            PG8_LDA(At, 1, 1); PG8_STAGE(PG8_SB(1, 0), b3, voffB); PG8_STAGE(PG8_SB(1, 1), b3 + hstep, voffB); PG8_STAGE(PG8_SA(1, 0), a3, voffA);
            PG8_WAIT_V(8); PG8_WAIT_L(0); PG8_BAR; PG8_MMA(1, 0, At, B0); PG8_MMA(1, 1, At, B1); PG8_BAR; PG8_SCHED;
            } else {
            PG8_LDB(B0, 0, 0); PG8_SCHED; PG8_LDA(At, 0, 0); PG8_STAGE(PG8_SA(1, 1), a1 + hstep, voffA);
            PG8_WAIT_L(8); PG8_BAR; PG8_WAIT_L(0); PG8_MMA(0, 0, At, B0); PG8_BAR; PG8_SCHED;
            PG8_LDB(B1, 0, 1); PG8_STAGE(PG8_SB(0, 0), b2, voffB);
            PG8_BAR; PG8_WAIT_L(0); PG8_MMA(0, 1, At, B1); PG8_BAR;
            PG8_LDA(At, 0, 1); PG8_STAGE(PG8_SA(0, 0), a2, voffA);
            PG8_BAR; PG8_WAIT_L(0); PG8_MMA(1, 0, At, B0); PG8_BAR; PG8_SCHED;
            PG8_STAGE(PG8_SB(0, 1), b2 + hstep, voffB);
            PG8_WAIT_V(6); PG8_BAR; PG8_MMA(1, 1, At, B1); PG8_BAR;
            PG8_LDB(B0, 1, 0); PG8_SCHED; PG8_LDA(At, 1, 0); PG8_STAGE(PG8_SA(0, 1), a2 + hstep, voffA);
            PG8_WAIT_L(8); PG8_BAR; PG8_WAIT_L(0); PG8_MMA(0, 0, At, B0); PG8_BAR; PG8_SCHED;
            PG8_LDB(B1, 1, 1); PG8_STAGE(PG8_SB(1, 0), b3, voffB);
            PG8_BAR; PG8_WAIT_L(0); PG8_MMA(0, 1, At, B1); PG8_BAR;
            PG8_LDA(At, 1, 1); PG8_STAGE(PG8_SA(1, 0), a3, voffA);
            PG8_BAR; PG8_WAIT_L(0); PG8_MMA(1, 0, At, B0); PG8_BAR; PG8_SCHED;
            PG8_STAGE(PG8_SB(1, 1), b3 + hstep, voffB);
            PG8_WAIT_V(6); PG8_BAR; PG8_MMA(1, 1, At, B1); PG8_BAR;
            }
        }
        if constexpr (ALIGN_EPI) { if (wr == 0) PG8_BAR; }
        if constexpr (!Epi::AFTER_DRAIN) { E(acc, cur, wr, wc, fr, fq, tid); S.done(cur); }
        if (!has_next) break;
#pragma unroll
        for (int a = 0; a < 2; ++a)
#pragma unroll
            for (int b = 0; b < 2; ++b)
#pragma unroll
                for (int m = 0; m < 4; ++m)
#pragma unroll
                    for (int n = 0; n < 2; ++n) acc[a][b][m][n] = (f32x4){0.f, 0.f, 0.f, 0.f};
        cur = nxt; cA = nA; cB = nB; ++ui;
        if constexpr (ALIGN_EPI) { if (wr == 1) PG8_BAR; }
    }
    PG8_WAIT_V(0);
    if constexpr (!ALIGN_EPI) { if (wr == 0) PG8_BAR; }
    PG8_BAR;
    static_assert(!Epi::AFTER_DRAIN, "no after-drain epilogues here");
#undef PG8_SA
#undef PG8_SB
#undef PG8_STAGE
#undef PG8_LDA
#undef PG8_LDB
#undef PG8_MMA
#undef PG8_WAIT_V
#undef PG8_WAIT_L
#undef PG8_BAR
#undef PG8_SCHED
}
}
#define GAS __attribute__((address_space(1)))
#define LAS __attribute__((address_space(3)))
typedef unsigned short bf16;
typedef unsigned v4u __attribute__((ext_vector_type(4)));
typedef float f32x4 __attribute__((ext_vector_type(4)));
typedef short bf16x8 __attribute__((ext_vector_type(8)));
typedef GAS unsigned gu32;
typedef GAS unsigned long long gu64;
#define RLX_AGENT __ATOMIC_RELAXED, __HIP_MEMORY_SCOPE_AGENT
#define LDS_WAIT() asm volatile("s_waitcnt lgkmcnt(0)" ::: "memory")
#define VM_WAIT() asm volatile("s_waitcnt vmcnt(0)" ::: "memory")
__device__ __forceinline__ unsigned long long rt() { return __builtin_amdgcn_s_memrealtime(); }
__device__ __forceinline__ unsigned f2bf(float f) { unsigned u = __builtin_bit_cast(unsigned, f); return (u + 0x7fffu + ((u >> 16) & 1u)) >> 16; }
__device__ __forceinline__ unsigned pk2(float lo, float hi) { return f2bf(lo) | (f2bf(hi) << 16); }

#define XB_TMO      128
#define XB_XCNT(j)  (256  + 64 * (j))
#define XB_XSUB(j)  (1280 + 64 * (j))
#define XB_XGEN(j)  (2304 + 64 * (j))
#define XB_TOP      3328
#define XB_TOPGEN   3392
#define XCD_BAR_WORDS 3456
#define XB_SPIN_CAP (1u << 22)

__device__ __forceinline__ unsigned xb_ld(unsigned* p)              { return __hip_atomic_load(p, __ATOMIC_RELAXED, __HIP_MEMORY_SCOPE_AGENT); }
__device__ __forceinline__ unsigned xb_add(unsigned* p, unsigned v) { return __hip_atomic_fetch_add(p, v, __ATOMIC_RELAXED, __HIP_MEMORY_SCOPE_AGENT); }
__device__ __forceinline__ unsigned xb_xcc_id() { return (unsigned)__builtin_amdgcn_s_getreg((3 << 11) | 20) & 0xFu; }
#define XB_SPIN(cond, bar) do { unsigned _sp = 0; while (cond) { __builtin_amdgcn_s_sleep(1); \
    if ((++_sp & 255u) == 0u) { if (xb_ld(&(bar)[XB_TMO])) break; if (_sp > XB_SPIN_CAP) { atomicAdd(&(bar)[XB_TMO], 1u); break; } } } } while (0)

struct XcdBarrier {
    unsigned* bar; unsigned x;
    volatile LAS unsigned* st;
};

__device__ __forceinline__ XcdBarrier xcd_barrier_post(unsigned* bar, volatile LAS unsigned* st) {
    XcdBarrier b; b.bar = bar; b.x = xb_xcc_id(); b.st = st;
    if (threadIdx.x == 0) (void)xb_add(&bar[XB_XCNT(b.x)], 1u);
    return b;
}
__device__ __forceinline__ void xcd_barrier_complete(unsigned* bar, unsigned x, unsigned& nloc, unsigned& nx) {
    const unsigned G = gridDim.x * gridDim.y * gridDim.z;
    unsigned sum, cnt, mine, sp = 0u;
    for (;;) {
        sum = 0u; cnt = 0u; mine = 0u;
#pragma unroll
        for (unsigned j = 0; j < 16; ++j) { const unsigned c = xb_ld(&bar[XB_XCNT(j)]); sum += c; cnt += (c > 0u) ? 1u : 0u; mine = (j == x) ? c : mine; }
        if (sum == G) break;
        __builtin_amdgcn_s_sleep(1);
        if ((++sp & 255u) == 0u) { if (xb_ld(&bar[XB_TMO])) break; if (sp > XB_SPIN_CAP) { atomicAdd(&bar[XB_TMO], 1u); break; } }
    }
    nloc = mine > 0u ? mine : 1u; nx = cnt > 0u ? cnt : 1u;
}

__device__ __forceinline__ void xcd_barrier(const XcdBarrier& b) {
    asm volatile("s_waitcnt vmcnt(0)" ::: "memory");
    __syncthreads();
    if (threadIdx.x == 0) {
        unsigned* bar = b.bar;
        __builtin_amdgcn_s_waitcnt(0);
        unsigned nloc = b.st[0], nx = b.st[1];
        if (nloc == 0u) { xcd_barrier_complete(bar, b.x, nloc, nx); b.st[0] = nloc; b.st[1] = nx; }
        const unsigned old = xb_add(&bar[XB_XSUB(b.x)], 1u);
        const unsigned gen = old / nloc;
        if (old + 1u == (gen + 1u) * nloc) {
            __builtin_amdgcn_fence(__ATOMIC_RELEASE, "agent");
            asm volatile("s_waitcnt vmcnt(0)" ::: "memory");
            const unsigned og = xb_add(&bar[XB_TOP], 1u);
            const unsigned tg = og / nx;
            if (og + 1u == (tg + 1u) * nx) xb_add(&bar[XB_TOPGEN], 1u);
            else XB_SPIN(xb_ld(&bar[XB_TOPGEN]) == tg, bar);
            __builtin_amdgcn_fence(__ATOMIC_ACQUIRE, "agent");
            xb_add(&bar[XB_XGEN(b.x)], 1u);
            asm volatile("s_waitcnt vmcnt(0)" ::: "memory");
        } else {
            XB_SPIN(xb_ld(&bar[XB_XGEN(b.x)]) == gen, bar);
            __builtin_amdgcn_fence(__ATOMIC_ACQUIRE, "agent");
            asm volatile("s_waitcnt vmcnt(0)" ::: "memory");
        }
    }
    __syncthreads();
}

template <class PF> __device__ __forceinline__ void xcd_barrier_pf(const XcdBarrier& b, PF&& prefetch) {
    asm volatile("s_waitcnt vmcnt(0)" ::: "memory");
    __syncthreads();
    if (threadIdx.x >= 64) prefetch();
    if (threadIdx.x == 0) {
        unsigned* bar = b.bar;
        __builtin_amdgcn_s_waitcnt(0);
        unsigned nloc = b.st[0], nx = b.st[1];
        if (nloc == 0u) { xcd_barrier_complete(bar, b.x, nloc, nx); b.st[0] = nloc; b.st[1] = nx; }
        const unsigned old = xb_add(&bar[XB_XSUB(b.x)], 1u);
        const unsigned gen = old / nloc;
        if (old + 1u == (gen + 1u) * nloc) {
            __builtin_amdgcn_fence(__ATOMIC_RELEASE, "agent");
            asm volatile("s_waitcnt vmcnt(0)" ::: "memory");
            const unsigned og = xb_add(&bar[XB_TOP], 1u);
            const unsigned tg = og / nx;
            if (og + 1u == (tg + 1u) * nx) xb_add(&bar[XB_TOPGEN], 1u);
            else XB_SPIN(xb_ld(&bar[XB_TOPGEN]) == tg, bar);
            __builtin_amdgcn_fence(__ATOMIC_ACQUIRE, "agent");
            xb_add(&bar[XB_XGEN(b.x)], 1u);
            asm volatile("s_waitcnt vmcnt(0)" ::: "memory");
        } else {
            XB_SPIN(xb_ld(&bar[XB_XGEN(b.x)]) == gen, bar);
            __builtin_amdgcn_fence(__ATOMIC_ACQUIRE, "agent");
            asm volatile("s_waitcnt vmcnt(0)" ::: "memory");
        }
    }
    __syncthreads();
}

struct GrpBarrier { unsigned* arr; unsigned* gen; unsigned* tmo; unsigned n; unsigned same; };
template <class PF> __device__ __forceinline__ void grp_barrier_pf(const GrpBarrier& gb, PF&& prefetch) {
    asm volatile("s_waitcnt vmcnt(0)" ::: "memory");
    __syncthreads();
    if (threadIdx.x >= 64) prefetch();
    if (threadIdx.x == 0) {
        __builtin_amdgcn_s_waitcnt(0);
        const unsigned old = xb_add(gb.arr, 1u), gen = old / gb.n;
        if (old + 1u == (gen + 1u) * gb.n) xb_add(gb.gen, 1u);
        else XB_SPIN(xb_ld(gb.gen) == gen, gb.tmo);
        __builtin_amdgcn_fence(__ATOMIC_ACQUIRE, "agent");
        asm volatile("s_waitcnt vmcnt(0)" ::: "memory");
    }
    __syncthreads();
}
__device__ __forceinline__ void grp_barrier(const GrpBarrier& gb) { grp_barrier_pf(gb, [] {}); }
namespace moba {
using bf16x8 = __attribute__((ext_vector_type(8))) short;
using s16x4 = __attribute__((ext_vector_type(4))) short;
using f32x16 = __attribute__((ext_vector_type(16))) float;
using u32x4 = __attribute__((ext_vector_type(4))) unsigned;
using f32x4 = __attribute__((ext_vector_type(4))) float;
typedef unsigned short bf16;
constexpr int NW = 8, QBLK = 32, QB = QBLK * NW, KVBLK = 64;
__device__ __forceinline__ int crow(int r, int hi) { return (r & 3) + 8 * (r >> 2) + 4 * hi; }
#define SBAR() __builtin_amdgcn_sched_barrier(0)
__device__ __forceinline__ void cmask(f32x16& p0, f32x16& p1, int jb, int qrel, int hi) {
    const float NEG = -INFINITY; int thr = qrel - 64 * jb - 4 * hi; asm volatile("" : "+v"(thr));
#pragma unroll
    for (int r = 0; r < 16; ++r) { const int c = (r & 3) + 8 * (r >> 2); if (c > thr) p0[r] = NEG; if (c + 32 > thr) p1[r] = NEG; }
}
constexpr int NSLOT = 3, SLOTB = 8192;
constexpr int LDS_K = 0, LDS_V = NSLOT * SLOTB, LDS_WS = 2 * NSLOT * SLOTB, LDS_OST = LDS_WS + NW * 64 * 4, LDS_BYTES = LDS_OST + NW * 8192;
constexpr float NEG_BIG = -1.0e30f;
__device__ __forceinline__ void glds16(const void* gsrc, unsigned lds_dst) { unsigned keep;
    asm volatile("s_mov_b32 %0, m0\n\ts_mov_b32 m0, %2\n\ts_nop 0\n\tglobal_load_lds_dwordx4 %1, off\n\ts_mov_b32 m0, %0" : "=&s"(keep) : "v"(gsrc), "s"(lds_dst) : "memory"); }
__device__ __forceinline__ float max3f(float a, float b, float c) { float r; asm("v_max3_f32 %0, %1, %2, %3" : "=v"(r) : "v"(a), "v"(b), "v"(c)); return r; }
__device__ __forceinline__ float max2f(float a, float b) { float r; asm("v_max_f32_e32 %0, %1, %2" : "=v"(r) : "v"(a), "v"(b)); return r; }
__device__ __forceinline__ float fadd_s(float a, float b) { float r; asm("v_add_f32_e32 %0, %1, %2" : "=v"(r) : "v"(a), "v"(b)); return r; }
__device__ __forceinline__ float fsub_s(float a, float b) { float r; asm("v_sub_f32_e32 %0, %1, %2" : "=v"(r) : "v"(a), "v"(b)); return r; }
typedef float f32x2_t __attribute__((ext_vector_type(2))); typedef __bf16 bf16x2_t __attribute__((ext_vector_type(2)));
__device__ __forceinline__ unsigned cvtpk_s(float lo, float hi) { f32x2_t v = {lo, hi}; bf16x2_t b = __builtin_convertvector(v, bf16x2_t); return __builtin_bit_cast(unsigned, b); }
#define WAIT_BAR(N) asm volatile("s_waitcnt vmcnt(" #N ") lgkmcnt(0)\n\ts_barrier" ::: "memory")
#define MFMA32(a, b, c) __builtin_amdgcn_mfma_f32_32x32x16_bf16(a, b, c, 0, 0, 0)
__device__ __forceinline__ unsigned fbits(float f) { return __builtin_bit_cast(unsigned, f); }
__device__ __forceinline__ float bitsf(unsigned u) { return __builtin_bit_cast(float, u); }
__device__ __forceinline__ float trunc16(float f) { return bitsf(fbits(f) & 0xffff0000u); }

typedef __attribute__((address_space(3))) const char* lds_cptr;
typedef short v4i16_t __attribute__((ext_vector_type(4)));
__device__ __forceinline__ void kload8(bf16x8* kf, lds_cptr kp) {
    kf[0] = *(const __attribute__((address_space(3))) bf16x8*)(kp);        kf[1] = *(const __attribute__((address_space(3))) bf16x8*)(kp + 512);
    kf[2] = *(const __attribute__((address_space(3))) bf16x8*)(kp + 2048); kf[3] = *(const __attribute__((address_space(3))) bf16x8*)(kp + 2560);
    kf[4] = *(const __attribute__((address_space(3))) bf16x8*)(kp + 4096); kf[5] = *(const __attribute__((address_space(3))) bf16x8*)(kp + 4608);
    kf[6] = *(const __attribute__((address_space(3))) bf16x8*)(kp + 6144); kf[7] = *(const __attribute__((address_space(3))) bf16x8*)(kp + 6656);
}
__device__ __forceinline__ void kload2(bf16x8* kf, lds_cptr kp, int j) { kf[2 * j] = *(const __attribute__((address_space(3))) bf16x8*)(kp + j * 2048); kf[2 * j + 1] = *(const __attribute__((address_space(3))) bf16x8*)(kp + j * 2048 + 512); }
__device__ __forceinline__ s16x4 vtr(lds_cptr p) { return __builtin_bit_cast(s16x4, __builtin_amdgcn_ds_read_tr16_b64_v4i16((__attribute__((address_space(3))) v4i16_t*)p)); }
__device__ __forceinline__ float rowmax(const f32x16& p0, const f32x16& p1) {
    float a = max3f(p0[0], p0[1], p1[0]), b = max3f(p0[2], p0[3], p1[1]); a = max3f(a, p1[2], p1[3]);
#pragma unroll
    for (int r = 4; r < 16; r += 4) { a = max3f(a, p0[r], p0[r + 1]); b = max3f(b, p0[r + 2], p0[r + 3]); a = max3f(a, p1[r], p1[r + 1]); b = max3f(b, p1[r + 2], p1[r + 3]); }
    const float m = max2f(a, b);
    auto rr = __builtin_amdgcn_permlane32_swap(__float_as_uint(m), __float_as_uint(m), false, false);
    return max2f(__uint_as_float(rr[0]), __uint_as_float(rr[1]));
}
__device__ __forceinline__ void pv(f32x16* o, int vb, bf16x8 pa0, bf16x8 pa1, bf16x8 pa2, bf16x8 pa3) {
#pragma unroll
    for (int d0 = 0; d0 < 2; ++d0) { s16x4 lo[4], hi[4];
#pragma unroll
        for (int ks = 0; ks < 4; ++ks) {
            asm volatile("ds_read_b64_tr_b16 %0,%1 offset:%c2" : "=&v"(lo[ks]) : "v"(vb), "i"(d0 * 4096 + ks * 1024) : "memory");
            asm volatile("ds_read_b64_tr_b16 %0,%1 offset:%c2" : "=&v"(hi[ks]) : "v"(vb), "i"(d0 * 4096 + ks * 1024 + 512) : "memory"); }
        asm volatile("s_waitcnt lgkmcnt(0)" ::: "memory"); SBAR();
#define PK(k) (bf16x8){lo[k][0], lo[k][1], lo[k][2], lo[k][3], hi[k][0], hi[k][1], hi[k][2], hi[k][3]}
        o[d0] = MFMA32(pa0, PK(0), o[d0]); o[d0] = MFMA32(pa1, PK(1), o[d0]); o[d0] = MFMA32(pa2, PK(2), o[d0]); o[d0] = MFMA32(pa3, PK(3), o[d0]);
#undef PK
    }
}
__device__ __forceinline__ bf16x8 kaug_frag(float kkf) {
    u32x4 w; const unsigned kb = fbits(kkf) >> 16;
    w[0] = kb | (kb << 16); w[1] = kb | 0x3f800000u; w[2] = 0x3f803f80u; w[3] = 0u; return __builtin_bit_cast(bf16x8, w);
}

#undef SBAR
#undef WAIT_BAR
#undef MFMA32
}
namespace mg {
using moba::bf16x8; using moba::s16x4; using moba::f32x16; using moba::u32x4; using moba::f32x4; using moba::bf16; using moba::lds_cptr;
using moba::glds16; using moba::cvtpk_s; using moba::fbits; using moba::bitsf; using moba::trunc16; using moba::kaug_frag; using moba::crow; using moba::cmask;
#define MG_MFMA(a, b, c) __builtin_amdgcn_mfma_f32_32x32x16_bf16(a, b, c, 0, 0, 0)
#define MG_SBAR() __builtin_amdgcn_sched_barrier(0)
#define MG_MX3(a, b, c) __builtin_fmaxf(__builtin_fmaxf((a), (b)), (c))
constexpr int LCAP = 4096;
constexpr int TSL = 16384;
typedef unsigned short u16;
typedef unsigned u32x2 __attribute__((ext_vector_type(2)));

__device__ __forceinline__ void pvT(f32x16* o, int vb, bf16x8 pa0, bf16x8 pa1, bf16x8 pa2, bf16x8 pa3) {
#pragma unroll
    for (int d0 = 0; d0 < 2; ++d0) { s16x4 lo[4], hi[4];
#pragma unroll
        for (int ks = 0; ks < 4; ++ks) {
            asm volatile("ds_read_b64_tr_b16 %0,%1 offset:%c2" : "=&v"(lo[ks]) : "v"(vb), "i"(d0 * 4096 + ks * 1024) : "memory");
            asm volatile("ds_read_b64_tr_b16 %0,%1 offset:%c2" : "=&v"(hi[ks]) : "v"(vb), "i"(d0 * 4096 + ks * 1024 + 512) : "memory"); }
        asm volatile("s_waitcnt lgkmcnt(0)" ::: "memory"); MG_SBAR();
#define PK(k) (bf16x8){lo[k][0], lo[k][1], lo[k][2], lo[k][3], hi[k][0], hi[k][1], hi[k][2], hi[k][3]}
        o[d0] = MG_MFMA(PK(0), pa0, o[d0]); o[d0] = MG_MFMA(PK(1), pa1, o[d0]); o[d0] = MG_MFMA(PK(2), pa2, o[d0]); o[d0] = MG_MFMA(PK(3), pa3, o[d0]);
#undef PK
    }
}
struct QAug { u32x4 w; unsigned sl_l16; };
__device__ __forceinline__ void qaug_init(QAug& a, float slope2, int hi) {
    const float sl_h = trunc16(slope2), sl_m = trunc16(slope2 - sl_h), sl_l = trunc16(slope2 - sl_h - sl_m);
    a.w[0] = hi ? 0u : ((fbits(sl_h) >> 16) | (fbits(sl_m) & 0xffff0000u)); a.w[1] = 0u; a.w[2] = 0u; a.w[3] = 0u; a.sl_l16 = hi ? 0u : (fbits(sl_l) >> 16);
}
__device__ __forceinline__ void qaug_rowterm(QAug& a, float rt, int hi) {
    const float rh = trunc16(rt), rm1 = rt - rh, rmm = trunc16(rm1), rl = rm1 - rmm;
    a.w[1] = hi ? 0u : (a.sl_l16 | (fbits(rh) & 0xffff0000u)); a.w[2] = hi ? 0u : ((fbits(rmm) >> 16) | (fbits(rl) & 0xffff0000u));
}
__device__ __forceinline__ void kfrag_load(bf16x8* kf, lds_cptr kp) {
#pragma unroll
    for (int d0 = 0; d0 < 4; ++d0) { kf[2 * d0] = *(const __attribute__((address_space(3))) bf16x8*)(kp + d0 * 2048); kf[2 * d0 + 1] = *(const __attribute__((address_space(3))) bf16x8*)(kp + d0 * 2048 + 512); }
}
template <int THRL> __device__ __forceinline__ void tile_step(f32x16* o, float& mhat, float& l_reg, QAug& qa, float rowoff, const bf16x8* qr, bf16x8* kf, lds_cptr knext, lds_cptr vp, float kk0, bool first, bool domask, int jb, int qrel, int hi) {
    f32x16 C0, C1;
    { float kkf = kk0; asm volatile("" : "+v"(kkf)); const f32x16 zero = f32x16{};
      C0 = MG_MFMA(kaug_frag(kkf), __builtin_bit_cast(bf16x8, qa.w), zero); C1 = MG_MFMA(kaug_frag(kkf + 32.f), __builtin_bit_cast(bf16x8, qa.w), zero);
#pragma unroll
      for (int d0 = 0; d0 < 4; ++d0) { C0 = MG_MFMA(kf[2 * d0], qr[d0], C0); C1 = MG_MFMA(kf[2 * d0 + 1], qr[d0], C1); } }
    MG_SBAR();
    s16x4 vl[8], vh[8];
#pragma unroll
    for (int i8 = 0; i8 < 8; ++i8) { vl[i8] = moba::vtr(vp + ((i8 >> 2) * 4096 + (i8 & 3) * 1024)); vh[i8] = moba::vtr(vp + ((i8 >> 2) * 4096 + (i8 & 3) * 1024 + 512)); }
    if (knext) kfrag_load(kf, knext);
    MG_SBAR();
    if (domask) cmask(C0, C1, jb, qrel, hi);
    float rm;
    { float a = MG_MX3(C0[0], C0[1], C1[0]), b_ = MG_MX3(C0[2], C0[3], C1[1]); a = MG_MX3(a, C1[2], C1[3]);
#pragma unroll
      for (int r = 4; r < 16; r += 4) { a = MG_MX3(a, C0[r], C0[r + 1]); b_ = MG_MX3(b_, C0[r + 2], C0[r + 3]); a = MG_MX3(a, C1[r], C1[r + 1]); b_ = MG_MX3(b_, C1[r + 2], C1[r + 3]); }
      rm = __builtin_fmaxf(a, b_); auto rr = __builtin_amdgcn_permlane32_swap(__float_as_uint(rm), __float_as_uint(rm), false, false); rm = __builtin_fmaxf(__uint_as_float(rr[0]), __uint_as_float(rr[1])); }
    if (first || __any(rm > (float)THRL)) {
        const float dl = first ? rm : __builtin_fmaxf(rm, 0.f); mhat += dl;
#pragma unroll
        for (int r = 0; r < 16; ++r) { C0[r] -= dl; C1[r] -= dl; }
        qaug_rowterm(qa, rowoff - mhat, hi);
        if (!first) { const float f = __builtin_amdgcn_exp2f(-dl); l_reg *= f;
#pragma unroll
            for (int r = 0; r < 16; ++r) { o[0][r] *= f; o[1][r] *= f; } }
    }
    float sa = 0.f, sb = 0.f;
#pragma unroll
    for (int r = 0; r < 16; ++r) { C0[r] = __builtin_amdgcn_exp2f(C0[r]); C1[r] = __builtin_amdgcn_exp2f(C1[r]); sa += C0[r]; sb += C1[r]; asm volatile("" : "+v"(sa), "+v"(sb)); }
    l_reg += sa + sb;
#define PKW(P, B) cvtpk_s(P[B], P[B + 1])
    const u32x4 pw0 = (u32x4){PKW(C0, 0), PKW(C0, 2), PKW(C0, 4), PKW(C0, 6)}, pw1 = (u32x4){PKW(C0, 8), PKW(C0, 10), PKW(C0, 12), PKW(C0, 14)}, pw2 = (u32x4){PKW(C1, 0), PKW(C1, 2), PKW(C1, 4), PKW(C1, 6)}, pw3 = (u32x4){PKW(C1, 8), PKW(C1, 10), PKW(C1, 12), PKW(C1, 14)};
#undef PKW
#define VFR(i) (bf16x8){vl[i][0], vl[i][1], vl[i][2], vl[i][3], vh[i][0], vh[i][1], vh[i][2], vh[i][3]}
    const bf16x8 pa0 = __builtin_bit_cast(bf16x8, pw0), pa1 = __builtin_bit_cast(bf16x8, pw1), pa2 = __builtin_bit_cast(bf16x8, pw2), pa3 = __builtin_bit_cast(bf16x8, pw3);
    o[0] = MG_MFMA(VFR(0), pa0, o[0]); o[1] = MG_MFMA(VFR(4), pa0, o[1]); o[0] = MG_MFMA(VFR(1), pa1, o[0]); o[1] = MG_MFMA(VFR(5), pa1, o[1]);
    o[0] = MG_MFMA(VFR(2), pa2, o[0]); o[1] = MG_MFMA(VFR(6), pa2, o[1]); o[0] = MG_MFMA(VFR(3), pa3, o[0]); o[1] = MG_MFMA(VFR(7), pa3, o[1]);
#undef VFR
}

__device__ __forceinline__ void mg_select(int vcu, int G, int wave, int lane, const bf16* Q, const float* kmeanP, unsigned* cnt, u16* lists) {
    const int r32 = lane & 31, hi = lane >> 5; const int NGW = G * 8;
    for (int gw = vcu * 8 + wave; gw < BATCH * NH * NBLK; gw += NGW) {
        const int bh = gw >> 4, cur = gw & 15; if (cur == 0) continue;
        const int b = bh >> 4, h = bh & 15;
        bf16x8 kmh[4], kml[4];
#pragma unroll
        for (int d0 = 0; d0 < 4; ++d0) {
            f32x4 a0 = (f32x4){0.f, 0.f, 0.f, 0.f}, a1 = a0;
            if (r32 < cur) { const float* p0 = kmeanP + (size_t)(b * NBLK + r32) * DM + h * HD + 16 * d0 + 8 * hi; const float* p1 = p0 + (size_t)BATCH * NBLK * DM;
                a0 = *(const f32x4*)p0 + *(const f32x4*)p1; a1 = *(const f32x4*)(p0 + 4) + *(const f32x4*)(p1 + 4); }
            u32x4 wh, wl;
#pragma unroll
            for (int e = 0; e < 2; ++e) { const float x0 = a0[2 * e], x1 = a0[2 * e + 1], y0 = a1[2 * e], y1 = a1[2 * e + 1];
                wh[e] = (fbits(x0) >> 16) | (fbits(x1) & 0xffff0000u); wh[2 + e] = (fbits(y0) >> 16) | (fbits(y1) & 0xffff0000u);
                wl[e] = cvtpk_s(x0 - trunc16(x0), x1 - trunc16(x1)); wl[2 + e] = cvtpk_s(y0 - trunc16(y0), y1 - trunc16(y1)); }
            kmh[d0] = __builtin_bit_cast(bf16x8, wh); kml[d0] = __builtin_bit_cast(bf16x8, wl);
        }
        const bf16* Qb0 = Q + ((size_t)bh * SEQ + cur * MBLK + r32) * HD + hi * 8;
        bf16x8 qn[4];
#pragma unroll
        for (int d0 = 0; d0 < 4; ++d0) qn[d0] = *reinterpret_cast<const bf16x8*>(&Qb0[d0 * 16]);
        unsigned sel3[8], mym[8]; unsigned total = 0u;
#pragma unroll
        for (int i = 0; i < 8; ++i) {
            bf16x8 qr[4];
#pragma unroll
            for (int d0 = 0; d0 < 4; ++d0) qr[d0] = qn[d0];
            if (i + 1 < 8) {
#pragma unroll
                for (int d0 = 0; d0 < 4; ++d0) qn[d0] = *reinterpret_cast<const bf16x8*>(&Qb0[(size_t)(i + 1) * 32 * HD + d0 * 16]); }
            f32x16 Gt = f32x16{};
#pragma unroll
            for (int d0 = 0; d0 < 4; ++d0) { Gt = MG_MFMA(kmh[d0], qr[d0], Gt); Gt = MG_MFMA(kml[d0], qr[d0], Gt); }
            float own[8], oth[8];
#pragma unroll
            for (int r = 0; r < 8; ++r) { own[r] = Gt[r]; oth[r] = __shfl_xor(own[r], 32); }
            float v1 = -INFINITY, v2 = -INFINITY, v3 = -INFINITY; int i1 = 15, i2 = 15, i3 = 15;
#pragma unroll
            for (int n = 0; n < 15; ++n) { const int idx = (n & 3) + 4 * (n >> 3); const bool mine = (((n >> 2) & 1) == hi);
                float g = mine ? own[idx] : oth[idx]; g = (n < cur) ? g : -INFINITY;
                const bool c1 = g > v1, c2 = g > v2, c3 = g > v3;
                v3 = c2 ? v2 : (c3 ? g : v3); i3 = c2 ? i2 : (c3 ? n : i3);
                v2 = c1 ? v1 : (c2 ? g : v2); i2 = c1 ? i1 : (c2 ? n : i2);
                v1 = c1 ? g : v1;             i1 = c1 ? n : i1; }
            sel3[i] = (unsigned)i1 | ((unsigned)i2 << 4) | ((unsigned)i3 << 8);
            unsigned mm = 0u;
            for (int n = 0; n < cur; ++n) { const bool m = (hi == 0) && (i1 == n || i2 == n || i3 == n); const unsigned long long mask = __ballot(m); if (lane == n) mm = (unsigned)mask; }
            mym[i] = mm; total += (unsigned)__popc(mm);
        }
        unsigned run = 0u;
        if (lane < cur && total != 0u) run = atomicAdd(cnt + bh * NBLK + lane, total);
        const unsigned below = (1u << r32) - 1u;
#pragma unroll
        for (int i = 0; i < 8; ++i) {
            const int s1 = (int)(sel3[i] & 15u), s2 = (int)((sel3[i] >> 4) & 15u), s3 = (int)((sel3[i] >> 8) & 15u); const int row = cur * MBLK + i * 32 + r32;
            const unsigned b1 = (unsigned)__shfl((int)run, s1), m1 = (unsigned)__shfl((int)mym[i], s1), b2 = (unsigned)__shfl((int)run, s2), m2 = (unsigned)__shfl((int)mym[i], s2), b3 = (unsigned)__shfl((int)run, s3), m3 = (unsigned)__shfl((int)mym[i], s3);
            if (hi == 0) {
                if (s1 != 15) lists[((size_t)(bh * NBLK + s1)) * LCAP + b1 + (unsigned)__popc(m1 & below)] = (u16)(row | (0 << 12));
                if (s2 != 15) lists[((size_t)(bh * NBLK + s2)) * LCAP + b2 + (unsigned)__popc(m2 & below)] = (u16)(row | (1 << 12));
                if (s3 != 15) lists[((size_t)(bh * NBLK + s3)) * LCAP + b3 + (unsigned)__popc(m3 & below)] = (u16)(row | (2 << 12)); }
            run += (unsigned)__popc(mym[i]);
        }
    }
}

template <int THRL> __device__ __forceinline__ void gather_chunk(bf16x8* qr, const bf16x8* qnx, const unsigned* ecur, const unsigned* enx, unsigned e, bool valid, int n, int buf, int bh, float slope2, lds_cptr shm3, unsigned lds0, int lane, int r32, int hi,
                                                                bf16* P0, bf16* P1, bf16* P2, float* ML) {
    const int row = (int)(e & 0xfffu), k = (int)(e >> 12);
    const float rowoff = slope2 * (float)(MBLK * (n - (row >> 8)));
    QAug qa; qaug_init(qa, slope2, hi); qaug_rowterm(qa, rowoff, hi);
    float mhat = 0.f, l_reg = 0.f; f32x16 o[2]; o[0] = f32x16{}; o[1] = f32x16{};
    const lds_cptr kb0 = shm3 + (buf * 4) * TSL + hi * 1024 + r32 * 16;
    const lds_cptr vb0 = shm3 + (buf * 4) * TSL + 8192 + ((lane >> 4) & 1) * 32 + (lane & 3) * 8 + (4 * hi + ((lane & 15) >> 2)) * 64;
    bf16x8 kf[8]; kfrag_load(kf, kb0 + 3 * TSL);
#pragma unroll 1
    for (int jt = 3; jt >= 0; --jt)
        tile_step<THRL>(o, mhat, l_reg, qa, rowoff, qr, kf, (jt > 0) ? kb0 + (jt - 1) * TSL : (lds_cptr)0, vb0 + jt * TSL, (float)(64 * jt + r32), jt == 3, false, 0, 0, hi);
    { auto rr = __builtin_amdgcn_permlane32_swap(__float_as_uint(l_reg), __float_as_uint(l_reg), false, false); l_reg = __uint_as_float(rr[0]) + __uint_as_float(rr[1]); }
    const float inv = __builtin_amdgcn_rcpf(l_reg);
    asm volatile("s_waitcnt vmcnt(0)" ::: "memory");
    if (qnx) {
#pragma unroll
        for (int d0 = 0; d0 < 4; ++d0) qr[d0] = qnx[d0];
        asm volatile("" : "+v"(qr[0]), "+v"(qr[1]), "+v"(qr[2]), "+v"(qr[3]) : "v"(ecur[0]), "v"(ecur[1]), "v"(ecur[2]), "v"(ecur[3]), "v"(ecur[4]), "v"(ecur[5]), "v"(ecur[6]), "v"(ecur[7]),
                     "v"(enx[0]), "v"(enx[1]), "v"(enx[2]), "v"(enx[3]), "v"(enx[4]), "v"(enx[5]), "v"(enx[6]), "v"(enx[7]) : "memory"); }
    if (valid) {
        bf16* Pk = (k == 0) ? P0 : (k == 1) ? P1 : P2;
        u32x4* dst = (u32x4*)(Pk + (((size_t)bh * SEQ + row) * 2 + hi) * 32);
#pragma unroll
        for (int d0 = 0; d0 < 2; ++d0)
#pragma unroll
            for (int q4 = 0; q4 < 2; ++q4) { u32x4 w;
#pragma unroll
                for (int e2 = 0; e2 < 4; ++e2) w[e2] = cvtpk_s(o[d0][8 * q4 + 2 * e2] * inv, o[d0][8 * q4 + 2 * e2 + 1] * inv);
                dst[d0 * 2 + q4] = w; }
        if (hi == 0) { float* ml = ML + (((size_t)bh * SEQ + row) * 3 + k) * 2; ml[0] = mhat; ml[1] = l_reg; }
    }
}

__device__ __forceinline__ void mg_gather_prefetch(char* shm, int vcu, int G, const bf16* K, const bf16* V) {
    if (G != 256) return;
    const int tid = threadIdx.x, lane = tid & 63; const int wid = __builtin_amdgcn_readfirstlane(tid >> 6);
    const int bh = vcu >> 1, half = vcu & 1; const long hb = (long)bh * SEQ * HD; const unsigned lds0 = (unsigned)(uintptr_t)shm;
    const bf16* ksrc = K + hb + (long)lane * HD + wid * 8; const bf16* vsrc = V + hb + (long)(16 * (wid & 3) + (lane >> 2)) * HD + (wid >> 2) * 32 + (lane & 3) * 8;
    const int n0 = half ? 3 : 0;
#pragma unroll
    for (int jt = 0; jt < 4; ++jt) { const long off = (long)(n0 * 4 + jt) * 64 * HD; const unsigned d = lds0 + (unsigned)jt * TSL + wid * 1024;
        glds16(ksrc + off, (unsigned)__builtin_amdgcn_readfirstlane(d)); glds16(vsrc + off, (unsigned)__builtin_amdgcn_readfirstlane(d + 8192)); }
}
__device__ __forceinline__ void mg_own_prefetch(char* shm, int vcu, int G, const bf16* K, const bf16* V) {
    if (G != 256) return;
    const int tid = threadIdx.x, lane = tid & 63; const int wid = __builtin_amdgcn_readfirstlane(tid >> 6);
    const int j0_ = vcu & 31, bh = (vcu >> 5) * NH + (j0_ >> 4), cur = j0_ & 15; const unsigned lds0 = (unsigned)(uintptr_t)shm;
    const long koff = (long)lane * HD + wid * 8, voff = (long)(16 * (wid & 3) + (lane >> 2)) * HD + (wid >> 2) * 32 + (lane & 3) * 8;
#pragma unroll
    for (int t = 0; t < 2; ++t) { const long base = ((long)bh * SEQ + (long)(4 * cur + t) * 64) * HD; const unsigned d = lds0 + (unsigned)t * TSL + wid * 1024;
        glds16(K + base + koff, (unsigned)__builtin_amdgcn_readfirstlane(d)); glds16(V + base + voff, (unsigned)__builtin_amdgcn_readfirstlane(d + 8192)); }
}

template <int THRL> __device__ __forceinline__ void mg_gather(char* shm, int vcu, int G, const bf16* Q, const bf16* __restrict__ K, const bf16* __restrict__ V, const unsigned* cnt, const u16* lists,
                                                             bf16* P0, bf16* P1, bf16* P2, float* ML, bool pf = false) {
    if (G != 256) return;
    const int tid = threadIdx.x, lane = tid & 63, r32 = lane & 31, hi = lane >> 5; const int wid = __builtin_amdgcn_readfirstlane(tid >> 6);
    const int bh = vcu >> 1, half = vcu & 1, b = bh >> 4, h = bh & 15; const long rowbase = (long)b * SEQ;
    const long hb = (long)bh * SEQ * HD; const bf16* Kh = K + hb, *Vh = V + hb; const bf16* Qh = Q + hb;
    const unsigned lds0 = (unsigned)(uintptr_t)shm; const lds_cptr shm3 = (lds_cptr)shm;
    const bf16* ksrc = Kh + (long)lane * HD + wid * 8;
    const bf16* vsrc = Vh + (long)(16 * (wid & 3) + (lane >> 2)) * HD + (wid >> 2) * 32 + (lane & 3) * 8;
    const float slope2 = exp2f(-0.5f * (float)(h + 1)) * LOG2E;
#define MG_DMA_BLOCK(n_, buf_) do { _Pragma("unroll") for (int jt_ = 0; jt_ < 4; ++jt_) { const long off_ = (long)((n_) * 4 + jt_) * 64 * HD; const unsigned d_ = lds0 + (unsigned)((buf_) * 4 + jt_) * TSL + wid * 1024; \
        glds16(ksrc + off_, (unsigned)__builtin_amdgcn_readfirstlane(d_)); glds16(vsrc + off_, (unsigned)__builtin_amdgcn_readfirstlane(d_ + 8192)); } } while (0)
    const unsigned long long seq = half ? 0xEDCBA987653ull : 0x4210ull; const int NU = half ? 11 : 4;
#define MG_UNIT(i_) ((int)((seq >> (4 * (i_))) & 15ull))
    if (!pf || wid == 0) MG_DMA_BLOCK(MG_UNIT(0), 0);
    unsigned rows_all = 0u; if (lane < NBLK - 1) rows_all = __hip_atomic_load(cnt + bh * NBLK + lane, __ATOMIC_RELAXED, __HIP_MEMORY_SCOPE_AGENT);
    const int j0 = wid;
    unsigned ecur[8], enx[8]; bf16x8 qnx[4];
#define MG_ENTRIES(dst, n_, rows_) do { const u16* l_ = lists + (size_t)(bh * NBLK + (n_)) * LCAP; _Pragma("unroll") for (int c_ = 0; c_ < 8; ++c_) { unsigned ix_ = (unsigned)(32 * (j0 + 8 * c_) + r32); \
        if (ix_ >= (rows_)) ix_ = (rows_) - 1u; dst[c_] = ((rows_) != 0u) ? (unsigned)l_[ix_] : 0u; } } while (0)
#define MG_QLOAD(e_) do { const bf16* q_ = Qh + (long)((e_) & 0xfffu) * HD + hi * 8; _Pragma("unroll") for (int d0 = 0; d0 < 4; ++d0) qnx[d0] = *reinterpret_cast<const bf16x8*>(&q_[d0 * 16]); } while (0)
    bf16x8 qr[4];
    { const int n0 = MG_UNIT(0); const unsigned r0 = (unsigned)__builtin_amdgcn_readlane((int)rows_all, n0); MG_ENTRIES(ecur, n0, r0); MG_QLOAD(ecur[0]);
#pragma unroll
      for (int d0 = 0; d0 < 4; ++d0) qr[d0] = qnx[d0]; }
    bool did = false;
    for (int ui = 0; ui < NU; ++ui) {
        const int n = MG_UNIT(ui), buf = ui & 1; const bool has_nx = ui + 1 < NU; const int nn = has_nx ? MG_UNIT(ui + 1) : 0;
        if (did) asm volatile("s_waitcnt vmcnt(5) lgkmcnt(0)\n\ts_barrier" ::: "memory"); else asm volatile("s_waitcnt vmcnt(0) lgkmcnt(0)\n\ts_barrier" ::: "memory");
        if (has_nx) MG_DMA_BLOCK(nn, buf ^ 1);
        const unsigned rows = (unsigned)__builtin_amdgcn_readlane((int)rows_all, n), rows_nx = has_nx ? (unsigned)__builtin_amdgcn_readlane((int)rows_all, nn) : 0u;
        const int nchunks = (int)((rows + 31u) >> 5), nch_nx = (int)((rows_nx + 31u) >> 5);
        if (has_nx) { MG_ENTRIES(enx, nn, rows_nx); } else {
#pragma unroll
            for (int c = 0; c < 8; ++c) enx[c] = 0u; }
        did = j0 < nchunks;
        if (!did && j0 < nch_nx) { MG_QLOAD(enx[0]);
#pragma unroll
            for (int d0 = 0; d0 < 4; ++d0) qr[d0] = qnx[d0]; }
#pragma unroll
        for (int c = 0; c < 8; ++c) { const int j = j0 + 8 * c; if (!(j < nchunks)) break; {
            const unsigned e = ecur[c]; const bool valid = (unsigned)(32 * j + r32) < rows;
            if (c + 1 < 8 && j + 8 < nchunks) { MG_QLOAD(ecur[(c + 1) & 7]); } else if (j0 < nch_nx) { MG_QLOAD(enx[0]); }
            gather_chunk<THRL>(qr, qnx, ecur, enx, e, valid, n, buf, bh, slope2, shm3, lds0, lane, r32, hi, P0, P1, P2, ML);
        } }
        for (int j = j0 + 64; j < nchunks; j += 8) {
            unsigned ix = (unsigned)(32 * j + r32); const bool valid = ix < rows; if (!valid) ix = rows - 1u;
            const unsigned e = (unsigned)(lists + (size_t)(bh * NBLK + n) * LCAP)[ix];
            const bf16* q_ = Qh + (long)(e & 0xfffu) * HD + hi * 8; bf16x8 qo[4];
#pragma unroll
            for (int d0 = 0; d0 < 4; ++d0) qo[d0] = *reinterpret_cast<const bf16x8*>(&q_[d0 * 16]);
            gather_chunk<THRL>(qo, (const bf16x8*)0, ecur, enx, e, valid, n, buf, bh, slope2, shm3, lds0, lane, r32, hi, P0, P1, P2, ML);
        }
#pragma unroll
        for (int c = 0; c < 8; ++c) ecur[c] = enx[c];
    }
    asm volatile("s_waitcnt vmcnt(0) lgkmcnt(0)\n\ts_barrier" ::: "memory");
#undef MG_DMA_BLOCK
#undef MG_UNIT
#undef MG_ENTRIES
#undef MG_QLOAD
}

constexpr int OWN_LDS_RING = 3 * TSL, OWN_STG_STRIDE = 68;
template <int THRL> __device__ __forceinline__ void mg_own_unit(int b, int h, int cur, int sigma, bool first_unit, int nb, int nh, int ncur, const bf16* Q, const bf16* __restrict__ K, const bf16* __restrict__ V, const bf16* Z,
                                                               const bf16* P0, const bf16* P1, const bf16* P2, const float* ML, bf16* O, char* shm, bool pf = false) {
    const int tid = threadIdx.x, lane = tid & 63, r32 = lane & 31, hi = lane >> 5; const int wid = __builtin_amdgcn_readfirstlane(tid >> 6);
    const int bh = b * NH + h; const long rowbase = (long)b * SEQ; const int q0 = cur * MBLK;
    const bf16* Qw = Q + ((long)bh * SEQ + q0 + wid * 32) * HD;
    const unsigned lds0 = (unsigned)(uintptr_t)shm; const lds_cptr shm3 = (lds_cptr)shm;
    const long koff = (long)lane * HD + wid * 8, voff = (long)(16 * (wid & 3) + (lane >> 2)) * HD + (wid >> 2) * 32 + (lane & 3) * 8;
#define MG_DMA_TILE(b_, h_, t_, slot_) do { const long base_ = (((long)(b_) * NH + (h_)) * SEQ + (long)(t_) * 64) * HD; const unsigned d_ = lds0 + (unsigned)(slot_) * TSL + wid * 1024; \
        glds16(K + base_ + koff, (unsigned)__builtin_amdgcn_readfirstlane(d_)); glds16(V + base_ + voff, (unsigned)__builtin_amdgcn_readfirstlane(d_ + 8192)); } while (0)
    if (first_unit && (!pf || wid == 0)) { MG_DMA_TILE(b, h, 4 * cur + 0, sigma % 3); MG_DMA_TILE(b, h, 4 * cur + 1, (sigma + 1) % 3); }
    bf16x8 qr[4];
#pragma unroll
    for (int d0 = 0; d0 < 4; ++d0) qr[d0] = *reinterpret_cast<const bf16x8*>(&Qw[(long)r32 * HD + d0 * 16 + hi * 8]);
    const float slope2 = exp2f(-0.5f * (float)(h + 1)) * LOG2E;
    QAug qa; qaug_init(qa, slope2, hi); qaug_rowterm(qa, 0.f, hi);
    float mhat = 0.f, l_reg = 0.f; f32x16 o[2]; o[0] = f32x16{}; o[1] = f32x16{};
    const int qrel = wid * 32 + r32;
    const int np = cur < 3 ? cur : 3; const int row = q0 + wid * 32 + r32;
    float mk[3], lk[3]; u32x4 pp[3][4]; u32x4 zw[4];
#pragma unroll 1
    for (int i = 0; i < 4; ++i) {
        asm volatile("s_waitcnt vmcnt(0) lgkmcnt(0)\n\ts_barrier" ::: "memory");
        if (i + 2 < 4) MG_DMA_TILE(b, h, 4 * cur + i + 2, (sigma + i + 2) % 3);
        if (i == 3 && ncur >= 0) { MG_DMA_TILE(nb, nh, 4 * ncur + 0, (sigma + 1) % 3); MG_DMA_TILE(nb, nh, 4 * ncur + 1, (sigma + 2) % 3); }
        if (i == 0) {
#pragma unroll
            for (int k = 0; k < 3; ++k) { if (k < np) { const float* ml = ML + (((size_t)bh * SEQ + row) * 3 + k) * 2; mk[k] = ml[0]; lk[k] = ml[1];
                    const bf16* Pk = (k == 0) ? P0 : (k == 1) ? P1 : P2; const u32x4* src = (const u32x4*)(Pk + (((size_t)bh * SEQ + row) * 2 + hi) * 32);
#pragma unroll
                    for (int q = 0; q < 4; ++q) pp[k][q] = src[q]; }
                else { mk[k] = 0.f; lk[k] = 0.f;
#pragma unroll
                    for (int q = 0; q < 4; ++q) pp[k][q] = (u32x4){0u, 0u, 0u, 0u}; } }
        }
        if (64 * i > 32 * wid + 31) continue;
        const int tb = ((sigma + i) % 3) * TSL;
        bf16x8 kf[8]; kfrag_load(kf, shm3 + tb + hi * 1024 + r32 * 16);
        tile_step<THRL>(o, mhat, l_reg, qa, 0.f, qr, kf, (lds_cptr)0, shm3 + tb + 8192 + ((lane >> 4) & 1) * 32 + (lane & 3) * 8 + (4 * hi + ((lane & 15) >> 2)) * 64, (float)(64 * i + r32), i == 0, 64 * i + 63 > 32 * wid, i, qrel, hi);
    }
    { const bf16* Zw = Z + ((long)bh * SEQ + q0 + wid * 32) * HD;
#pragma unroll
      for (int q = 0; q < 4; ++q) zw[q] = *(const u32x4*)(Zw + (long)(q * 8 + (lane >> 3)) * HD + (lane & 7) * 8); }
    { auto rr = __builtin_amdgcn_permlane32_swap(__float_as_uint(l_reg), __float_as_uint(l_reg), false, false); l_reg = __uint_as_float(rr[0]) + __uint_as_float(rr[1]); }
    float M = mhat;
#pragma unroll
    for (int k = 0; k < 3; ++k) if (k < np) M = __builtin_fmaxf(M, mk[k]);
    const float wo = __builtin_amdgcn_exp2f(mhat - M); float den = l_reg * wo;
#pragma unroll
    for (int r = 0; r < 16; ++r) { o[0][r] *= wo; o[1][r] *= wo; }
#pragma unroll
    for (int k = 0; k < 3; ++k) { if (k < np) { const float wk = lk[k] * __builtin_amdgcn_exp2f(mk[k] - M); den += wk;
#pragma unroll
            for (int d0 = 0; d0 < 2; ++d0)
#pragma unroll
                for (int q4 = 0; q4 < 2; ++q4) { const u32x4 w = pp[k][d0 * 2 + q4];
#pragma unroll
                    for (int e2 = 0; e2 < 4; ++e2) { o[d0][8 * q4 + 2 * e2] += wk * bitsf(w[e2] << 16); o[d0][8 * q4 + 2 * e2 + 1] += wk * bitsf(w[e2] & 0xffff0000u); } } } }
    const float inv = __builtin_amdgcn_rcpf(den);
    { float* stg = (float*)(shm + OWN_LDS_RING) + wid * (32 * OWN_STG_STRIDE);
#pragma unroll
      for (int d0 = 0; d0 < 2; ++d0)
#pragma unroll
          for (int m = 0; m < 4; ++m) *(f32x4*)(stg + r32 * OWN_STG_STRIDE + d0 * 32 + m * 8 + 4 * hi) = (f32x4){o[d0][4 * m] * inv, o[d0][4 * m + 1] * inv, o[d0][4 * m + 2] * inv, o[d0][4 * m + 3] * inv};
      asm volatile("s_waitcnt lgkmcnt(0)" ::: "memory");
      int lane_e = lane; asm volatile("" : "+v"(lane_e));
      bf16* Ow = O + (rowbase + q0 + wid * 32) * DM + h * HD;
#pragma unroll
      for (int i = 0; i < 4; ++i) { const int rw = i * 8 + (lane_e >> 3), ch = lane_e & 7;
          const f32x4 x0 = *(const f32x4*)(stg + rw * OWN_STG_STRIDE + ch * 8), x1 = *(const f32x4*)(stg + rw * OWN_STG_STRIDE + ch * 8 + 4);
          float zz[8] = {bitsf(zw[i][0] << 16), bitsf(zw[i][0] & 0xffff0000u), bitsf(zw[i][1] << 16), bitsf(zw[i][1] & 0xffff0000u), bitsf(zw[i][2] << 16), bitsf(zw[i][2] & 0xffff0000u), bitsf(zw[i][3] << 16), bitsf(zw[i][3] & 0xffff0000u)};
          float xs[8] = {x0[0], x0[1], x0[2], x0[3], x1[0], x1[1], x1[2], x1[3]}; float rr_[8];
#pragma unroll
          for (int e = 0; e < 8; ++e) { const float sg = __builtin_amdgcn_rcpf(1.0f + __builtin_amdgcn_exp2f(-LOG2E * zz[e])); rr_[e] = xs[e] * zz[e] * sg; }
          u32x4 ov; ov[0] = cvtpk_s(rr_[0], rr_[1]); ov[1] = cvtpk_s(rr_[2], rr_[3]); ov[2] = cvtpk_s(rr_[4], rr_[5]); ov[3] = cvtpk_s(rr_[6], rr_[7]);
          *(u32x4*)(Ow + (long)rw * DM + ch * 8) = ov; }
      asm volatile("s_waitcnt lgkmcnt(0)" ::: "memory"); }
#undef MG_DMA_TILE
}
template <int THRL> __device__ __forceinline__ void mg_own(char* lds, int vcu, int G, const bf16* Q, const bf16* K, const bf16* V, const bf16* Z, const bf16* P0, const bf16* P1, const bf16* P2, const float* ML, bf16* O, bool pf = false) {
    int sigma = 0; bool first = true;
    if (G != 256) return;
    for (int k = 0; k < 8; ++k) { const int j = (vcu & 31) + 32 * k, bh = (vcu >> 5) * NH + (j >> 4), cur = j & 15; const bool hn = k + 1 < 8; const int jn = j + 32, bhn = (vcu >> 5) * NH + (jn >> 4);
        mg_own_unit<THRL>(bh >> 4, bh & 15, cur, sigma, first, hn ? (bhn >> 4) : 0, hn ? (bhn & 15) : 0, hn ? (jn & 15) : -1, Q, K, V, Z, P0, P1, P2, ML, O, lds, pf);
        sigma = (sigma + 1) % 3; first = false; }
    asm volatile("s_waitcnt vmcnt(0) lgkmcnt(0)\n\ts_barrier" ::: "memory");
}
#undef MG_MFMA
#undef MG_SBAR
#undef MG_MX3
}
namespace sbk {
using moba::bf16x8; using moba::s16x4; using moba::f32x16; using moba::u32x4; using moba::f32x4; using moba::bf16; using moba::lds_cptr;
using moba::glds16; using moba::cvtpk_s; using moba::fbits; using moba::bitsf;
constexpr int NW = 8, QBLK = 32, QB = 256, KVBLK = 64, NSLOT = 6, TSLOT = 16384;
constexpr int LDS_RING = 0, LDS_STG = NSLOT * TSLOT, LDS_FLAG = 131072 + 1024;
#define SB_MFMA(a, b, c) __builtin_amdgcn_mfma_f32_32x32x16_bf16(a, b, c, 0, 0, 0)
#define SB_SBAR() __builtin_amdgcn_sched_barrier(0)
constexpr float CARRY_EXIT = 7.8886090522101181e-31f;

template <bool DIAG> __device__ __forceinline__ void sb_tile(f32x16* o, float& carry, const bf16x8* qr, lds_cptr kp, lds_cptr vp, int rowrel, int hi) {
    f32x16 C0, C1;
    { const f32x16 zero = f32x16{};
#pragma unroll
      for (int d0 = 0; d0 < 4; ++d0) { const bf16x8 b0 = *(const __attribute__((address_space(3))) bf16x8*)(kp + d0 * 2048); const bf16x8 b1 = *(const __attribute__((address_space(3))) bf16x8*)(kp + d0 * 2048 + 512);
          if (d0 == 0) { C0 = SB_MFMA(b0, qr[0], zero); C1 = SB_MFMA(b1, qr[0], zero); } else { C0 = SB_MFMA(b0, qr[d0], C0); C1 = SB_MFMA(b1, qr[d0], C1); } } }
    SB_SBAR();
    s16x4 vl[8], vh[8];
#pragma unroll
    for (int i8 = 0; i8 < 8; ++i8) { vl[i8] = moba::vtr(vp + ((i8 >> 2) * 4096 + (i8 & 3) * 1024)); vh[i8] = moba::vtr(vp + ((i8 >> 2) * 4096 + (i8 & 3) * 1024 + 512)); }
    SB_SBAR();
    float g[2][16];
#pragma unroll
    for (int r = 0; r < 16; ++r) { g[0][r] = __builtin_amdgcn_rcpf(1.0f + __builtin_amdgcn_exp2f(C0[r])); g[1][r] = __builtin_amdgcn_rcpf(1.0f + __builtin_amdgcn_exp2f(C1[r])); }
    if (DIAG) { int thr = rowrel - 4 * hi; asm volatile("" : "+v"(thr));
#pragma unroll
        for (int r = 0; r < 16; ++r) { const int c = (r & 3) + 8 * (r >> 2); if (!(c < thr)) g[0][r] = 1.f; if (!(c + 32 < thr)) g[1][r] = 1.f; } }
    float E1[8], E0[8], Gt[8], Cp[8], Pt[8];
#pragma unroll
    for (int u = 0; u < 8; ++u) { const int h = u >> 2, r0 = 4 * (u & 3);
        E1[u] = g[h][r0 + 3] * g[h][r0 + 2]; E0[u] = E1[u] * g[h][r0 + 1]; Gt[u] = E0[u] * g[h][r0];
        auto rr = __builtin_amdgcn_permlane32_swap(__float_as_uint(Gt[u]), __float_as_uint(Gt[u]), false, false);
        const float x0 = __uint_as_float(rr[0]), x1 = __uint_as_float(rr[1]);
        Cp[u] = x0 * x1; Pt[u] = hi ? 1.0f : x1; }
    float off[8]; { float s = carry;
#pragma unroll
      for (int u = 7; u >= 0; --u) { off[u] = s * Pt[u]; s *= Cp[u]; }
      carry = s; }
    u32x4 pw[4];
#pragma unroll
    for (int u = 0; u < 8; ++u) { const int h = u >> 2, r0 = 4 * (u & 3); const float f = off[u];
        const float F2 = g[h][r0 + 3] * f, F1 = E1[u] * f, F0 = E0[u] * f, Fm = Gt[u] * f;
        const float w3 = f - F2, w2 = F2 - F1, w1 = F1 - F0, w0 = F0 - Fm;
        pw[2 * h + ((u & 3) >> 1)][2 * (u & 1)] = cvtpk_s(w0, w1); pw[2 * h + ((u & 3) >> 1)][2 * (u & 1) + 1] = cvtpk_s(w2, w3); }
#define VFR(i) (bf16x8){vl[i][0], vl[i][1], vl[i][2], vl[i][3], vh[i][0], vh[i][1], vh[i][2], vh[i][3]}
    const bf16x8 pa0 = __builtin_bit_cast(bf16x8, pw[0]), pa1 = __builtin_bit_cast(bf16x8, pw[1]), pa2 = __builtin_bit_cast(bf16x8, pw[2]), pa3 = __builtin_bit_cast(bf16x8, pw[3]);
    o[0] = SB_MFMA(pa0, VFR(0), o[0]); o[1] = SB_MFMA(pa0, VFR(4), o[1]); o[0] = SB_MFMA(pa1, VFR(1), o[0]); o[1] = SB_MFMA(pa1, VFR(5), o[1]);
    o[0] = SB_MFMA(pa2, VFR(2), o[0]); o[1] = SB_MFMA(pa2, VFR(6), o[1]); o[0] = SB_MFMA(pa3, VFR(3), o[0]); o[1] = SB_MFMA(pa3, VFR(7), o[1]);
#undef VFR
}

__device__ __forceinline__ void sb_sweep(int b, int h, int qb_hi, int qb_lo, const bf16* Q, const bf16* __restrict__ K, const bf16* __restrict__ V, const bf16* Z, bf16* O, char* shm) {
    const int tid = threadIdx.x, lane = tid & 63, r32 = lane & 31, hi = lane >> 5; const int wid = __builtin_amdgcn_readfirstlane(tid >> 6);
    const long rowbase = (long)b * SEQ; const int j2 = wid >> 1;
    const long hb = (long)(b * NH + h) * SEQ * HD; const bf16* Kh = K + hb, *Vh = V + hb;
    const unsigned lds0 = (unsigned)(uintptr_t)shm; const lds_cptr shm3 = (lds_cptr)shm;
    const bf16* ksrc = Kh + (long)lane * HD + wid * 8;
    const bf16* vsrc = Vh + (long)(16 * (wid & 3) + (lane >> 2)) * HD + (wid >> 2) * 32 + (lane & 3) * 8;
#define SB_DMA(T_) do { const long off_ = (long)(T_) * KVBLK * HD; const unsigned so_ = lds0 + (unsigned)((T_) % NSLOT) * TSLOT + wid * 1024; \
        glds16(ksrc + off_, (unsigned)__builtin_amdgcn_readfirstlane(so_)); glds16(vsrc + off_, (unsigned)__builtin_amdgcn_readfirstlane(so_ + 8192)); } while (0)
    const lds_cptr kp0 = shm3 + hi * 1024 + r32 * 16;
    const lds_cptr vp0 = shm3 + 8192 + ((lane >> 4) & 1) * 32 + (lane & 3) * 8 + (4 * hi + ((lane & 15) >> 2)) * 64;
    typedef volatile __attribute__((address_space(3))) unsigned* lds_vu32p;
    lds_vu32p flags = (lds_vu32p)(shm3 + LDS_FLAG);
    const int rowrel = 32 * (wid & 1) + r32;
    int next_T = -100;
    bf16x8 qn[4];
    for (int qb = qb_hi; qb >= qb_lo; --qb) {
        const int q0 = qb * QB, T0 = 4 * qb, top = T0 + 3;
        const bf16* Qw = Q + (hb + (long)(q0 + wid * QBLK) * HD);
        bf16x8 qr[4];
        if (qb == qb_hi) {
#pragma unroll
            for (int d0 = 0; d0 < 4; ++d0) qr[d0] = *reinterpret_cast<const bf16x8*>(&Qw[(long)r32 * HD + d0 * 16 + hi * 8]); }
        else {
#pragma unroll
            for (int d0 = 0; d0 < 4; ++d0) qr[d0] = qn[d0]; }
        asm volatile("" : "+v"(qr[0]), "+v"(qr[1]), "+v"(qr[2]), "+v"(qr[3]));
        if (next_T < 0 && qb != qb_hi) next_T = -1;
        if (qb == qb_hi || top > next_T + NSLOT) {
            asm volatile("s_waitcnt vmcnt(0) lgkmcnt(0)\n\ts_barrier" ::: "memory");
            next_T = top; }
        { const int lowt = T0 - 2 > 0 ? T0 - 2 : 0; while (next_T >= lowt) { SB_DMA(next_T); --next_T; } }
        float carry = 1.f; f32x16 o[2]; o[0] = f32x16{}; o[1] = f32x16{};
        bool walking = true;
        u32x4 zq[4];
        for (int i = 0;; ++i) {
            { const int L = T0 - i > 0 ? T0 - i : 0; const int k = L - 1 - next_T;
              const bool rel = (i == 2) || (i == 3);
              if (k >= 2) { asm volatile("s_waitcnt vmcnt(4) lgkmcnt(0)\n\ts_barrier" ::: "memory"); }
              else if (k == 1) { if (rel) asm volatile("s_waitcnt vmcnt(10) lgkmcnt(0)\n\ts_barrier" ::: "memory"); else asm volatile("s_waitcnt vmcnt(2) lgkmcnt(0)\n\ts_barrier" ::: "memory"); }
              else { if (rel) asm volatile("s_waitcnt vmcnt(8) lgkmcnt(0)\n\ts_barrier" ::: "memory"); else asm volatile("s_waitcnt vmcnt(0) lgkmcnt(0)\n\ts_barrier" ::: "memory"); } }
            if (i > 1) { lds_vu32p fl = flags + 8 * ((i - 1) & 1); unsigned any = 0u;
#pragma unroll
                for (int w_ = 0; w_ < 8; ++w_) any |= fl[w_];
                if (any == 0u) break; }
            { const int tg = T0 - i - 2; if (tg >= 0 && next_T >= tg) { SB_DMA(next_T); --next_T; } }
            if (i == 1) { const bf16* Zw = Z + (hb + (long)(q0 + wid * QBLK) * HD);
#pragma unroll
                for (int q = 0; q < 4; ++q) zq[q] = *(const u32x4*)(Zw + (long)((q & 1) * 16 + (lane >> 2)) * HD + (q >> 1) * 32 + (lane & 3) * 8);
                { const int back = (qb > qb_lo) ? QB : 0;
#pragma unroll
                  for (int d0 = 0; d0 < 4; ++d0) qn[d0] = *reinterpret_cast<const bf16x8*>(&Qw[(long)(r32 - back) * HD + d0 * 16 + hi * 8]); } }
            const int T = T0 + j2 - i;
            if (walking && T >= 0) {
                const int so = (T % NSLOT) * TSLOT;
                if (i == 0) sb_tile<true>(o, carry, qr, kp0 + so, vp0 + so, rowrel, hi); else sb_tile<false>(o, carry, qr, kp0 + so, vp0 + so, rowrel, hi);
                if (__all(carry < CARRY_EXIT)) walking = false;
            }
            if (lane == 0) flags[8 * (i & 1) + wid] = (walking && (T - 1 >= 0)) ? 1u : 0u;
        }
        { float* stg = (float*)(shm + LDS_STG) + wid * 1024;
          int lane_e = lane; asm volatile("" : "+v"(lane_e));
          bf16* Ow = O + (rowbase + q0 + wid * QBLK) * DM + h * HD;
#pragma unroll
          for (int d0 = 0; d0 < 2; ++d0) {
#pragma unroll
              for (int r = 0; r < 16; ++r) stg[moba::crow(r, hi) * 32 + r32] = o[d0][r];
              asm volatile("s_waitcnt lgkmcnt(0)" ::: "memory");
#pragma unroll
              for (int i2 = 0; i2 < 2; ++i2) { const int row = i2 * 16 + (lane_e >> 2), ch = lane_e & 3;
                  const f32x4 x0 = *(const f32x4*)(stg + row * 32 + ch * 8), x1 = *(const f32x4*)(stg + row * 32 + ch * 8 + 4);
                  const u32x4 zv = zq[2 * d0 + i2];
                  float zz[8] = {bitsf(zv[0] << 16), bitsf(zv[0] & 0xffff0000u), bitsf(zv[1] << 16), bitsf(zv[1] & 0xffff0000u), bitsf(zv[2] << 16), bitsf(zv[2] & 0xffff0000u), bitsf(zv[3] << 16), bitsf(zv[3] & 0xffff0000u)};
                  float xs[8] = {x0[0], x0[1], x0[2], x0[3], x1[0], x1[1], x1[2], x1[3]}; float rr_[8];
#pragma unroll
                  for (int e = 0; e < 8; ++e) { const float sg = __builtin_amdgcn_rcpf(1.0f + __builtin_amdgcn_exp2f(-LOG2E * zz[e])); rr_[e] = xs[e] * zz[e] * sg; }
                  u32x4 ov; ov[0] = cvtpk_s(rr_[0], rr_[1]); ov[1] = cvtpk_s(rr_[2], rr_[3]); ov[2] = cvtpk_s(rr_[4], rr_[5]); ov[3] = cvtpk_s(rr_[6], rr_[7]);
                  *(u32x4*)(Ow + (long)row * DM + d0 * 32 + ch * 8) = ov; }
              asm volatile("s_waitcnt lgkmcnt(0)" ::: "memory"); }
        }
    }
    asm volatile("s_waitcnt vmcnt(0) lgkmcnt(0)\n\ts_barrier" ::: "memory");
#undef SB_DMA
}
__device__ __forceinline__ void sb_phase(char* lds, int vcu, int G, const bf16* Q, const bf16* K, const bf16* V, const bf16* Z, bf16* O) {
    if (G == 256) { const int bh = vcu >> 1, half = vcu & 1; sb_sweep(bh >> 4, bh & 15, half ? 7 : 15, half ? 0 : 8, Q, K, V, Z, O, lds); }
    else { for (int u = vcu; u < BATCH * NH * 2; u += G) { const int bh = u >> 1, half = u & 1; sb_sweep(bh >> 4, bh & 15, half ? 7 : 15, half ? 0 : 8, Q, K, V, Z, O, lds); } }
}
#undef SB_MFMA
#undef SB_SBAR
}
constexpr int NWAVES = 8;
constexpr int N_LAUNCHES = MK_N_LAUNCHES;
constexpr int PER_PHASE = 7;
constexpr size_t MiB = 1u << 20;
constexpr size_t WS_CTL = 0, CTL_ZERO_BYTES = 144 * 1024;
constexpr size_t WS_WIN = 2 * MiB;
constexpr size_t WS_WOUT = 18 * MiB;
constexpr size_t WS_RSTD0 = 22 * MiB;
constexpr size_t WS_SSQ1 = WS_RSTD0 + 512 * 1024;
constexpr size_t WS_SSQ2 = WS_SSQ1 + 512 * 1024;
constexpr size_t WS_KMEAN = 24 * MiB;
constexpr size_t WS_XB = 32 * MiB;
constexpr size_t WS_QKVZ = 96 * MiB;
constexpr size_t WS_OG = 352 * MiB;
constexpr size_t WS_ML = 416 * MiB;
constexpr size_t WS_LISTS = 432 * MiB;
constexpr size_t WS_END = 448 * MiB;
constexpr int CW_SEAM = 16384;
static_assert((32768 + BATCH * NH * NBLK) * 4 <= 144 * 1024, "control words inside the per-call memset");
constexpr int CW_LCNT = 32768;
constexpr int CW_GRP = 8192;
constexpr int CW_BAR = 4096;

constexpr int RING_OFF = 0, RING_BYTES = 131072;
constexpr int LDSCTL_OFF = RING_BYTES, MISC_OFF = LDSCTL_OFF + 320;
constexpr int EPI_OFF = RING_BYTES + 1024;
constexpr int LDS_BYTES = 147456;
static_assert(EPI_OFF + 4096 + 256 <= LDS_BYTES && MISC_OFF + 128 <= EPI_OFF, "LDS map");

struct Frame {
    LAS unsigned char* lds;
    volatile LAS unsigned* MISC;
    gu32* ctl;
    int tid, lane, wave, vcu, G, grp;
};

__device__ __forceinline__ int vzero() { int z; asm volatile("v_mov_b32 %0, 0" : "=v"(z)); return z; }
__device__ __forceinline__ float bf_lo(unsigned u) { return __builtin_bit_cast(float, u << 16); }
__device__ __forceinline__ float bf_hi(unsigned u) { return __builtin_bit_cast(float, u & 0xffff0000u); }
__device__ __forceinline__ float wave_sum(float v) {
#pragma unroll
    for (int o = 1; o < 64; o <<= 1) v += __shfl_xor(v, o);
    return v;
}

__device__ __forceinline__ void p0_transpose_item(const float* W, const float* g, int K, int N, bf16* WT, LAS float* scr, int item, int lane) {
    const int nblk = N / 32, kb = item / nblk, nb = item % nblk, k0 = 64 * kb, n0 = 32 * nb;
#pragma unroll 8
    for (int i = 0; i < 32; ++i) { const int kk = 2 * i + (lane >> 5); const float sc = g ? g[k0 + kk] : 1.f; scr[kk * 33 + (lane & 31)] = W[(size_t)(k0 + kk) * N + n0 + (lane & 31)] * sc; }
    LDS_WAIT(); asm volatile("" ::: "memory");
    const int c = lane & 7;
#pragma unroll
    for (int j = 0; j < 4; ++j) { const int n = (lane >> 3) + 8 * j; const LAS float* s = scr + (8 * c) * 33 + n;
        v4u o; o.x = pk2(s[0 * 33], s[1 * 33]); o.y = pk2(s[2 * 33], s[3 * 33]); o.z = pk2(s[4 * 33], s[5 * 33]); o.w = pk2(s[6 * 33], s[7 * 33]);
        *(GAS v4u*)(WT + (size_t)(n0 + n) * K + k0 + 8 * c) = o; }
    LDS_WAIT(); asm volatile("" ::: "memory");
}
__device__ __forceinline__ void p0_prologue(Frame& F, const float* x, const float* norm_g, const float* w_in, const float* w_out, unsigned char* ws) {
    LAS float* scr = (LAS float*)(F.lds + RING_OFF + F.wave * 16384);
    const int gw = F.vcu * NWAVES + F.wave, NGW = F.G * NWAVES;
    constexpr int I_IN = (DM / 64) * (NIN / 32), I_OUT = (DM / 64) * (DM / 32);
    constexpr int NITEMS = DEPTH * (I_IN + I_OUT);
    for (int it = gw; it < NITEMS; it += NGW) {
        int r = it; const int l = r / (I_IN + I_OUT); r -= l * (I_IN + I_OUT);
        if (r < I_IN) p0_transpose_item(w_in + (size_t)l * DM * NIN, norm_g + l * DM, DM, NIN, (bf16*)(ws + WS_WIN) + (size_t)l * NIN * DM, scr, r, F.lane);
        else p0_transpose_item(w_out + (size_t)l * DM * DM, nullptr, DM, DM, (bf16*)(ws + WS_WOUT) + (size_t)l * DM * DM, scr, r - I_IN, F.lane);
    }
    bf16* XB = (bf16*)(ws + WS_XB); float* rstd0 = (float*)(ws + WS_RSTD0);
    for (int m = gw; m < MROWS; m += NGW) {
        const GAS f32x4* xr = (const GAS f32x4*)(x + (size_t)m * DM) + F.lane; f32x4 v[4]; float s = 0.f;
#pragma unroll
        for (int j = 0; j < 4; ++j) { v[j] = xr[64 * j]; s += (v[j].x * v[j].x + v[j].y * v[j].y) + (v[j].z * v[j].z + v[j].w * v[j].w); }
        s = wave_sum(s);
        if (F.lane == 0) rstd0[m] = 1.0f / sqrtf(s * (1.0f / DM) + NORM_EPS);
        GAS unsigned long long* o8 = (GAS unsigned long long*)(XB + (size_t)m * DM) + F.lane;
#pragma unroll
        for (int j = 0; j < 4; ++j) o8[64 * j] = (unsigned long long)pk2(v[j].x, v[j].y) | ((unsigned long long)pk2(v[j].z, v[j].w) << 32);
    }
}

#ifndef MG_PROBE
#define MG_PROBE 0
#endif
#ifndef REPEAT_PHASE
#define REPEAT_PHASE -1
#endif
#define REPS(k) for (int rep_ = 0; rep_ < ((REPEAT_PHASE == (k)) ? 2 : 1); ++rep_)
#ifndef GEMM_DESYNC_TICKS
#define GEMM_DESYNC_TICKS 0
#endif
__device__ __forceinline__ void desync_delay(int ticks) {
    if (ticks > 0 && (blockIdx.x & 1)) { const unsigned long long t0 = __builtin_amdgcn_s_memrealtime(); while (__builtin_amdgcn_s_memrealtime() - t0 < (unsigned long long)ticks) __builtin_amdgcn_s_sleep(8); }
}
struct Args { const float* in[5]; float* out; unsigned char* ws; int ph_lo, ph_hi; };
__global__ void __launch_bounds__(NWAVES * 64, 2) trunk_fwd(Args args) {
    extern __shared__ __attribute__((aligned(16))) unsigned char lds[];
    Frame F;
    F.lds = (LAS unsigned char*)lds; F.MISC = (volatile LAS unsigned*)(F.lds + MISC_OFF);
    F.tid = threadIdx.x; F.lane = F.tid & 63; F.wave = __builtin_amdgcn_readfirstlane(F.tid >> 6);
    F.G = gridDim.x; { const int bx = blockIdx.x; F.vcu = (F.G % 8 == 0) ? (bx % 8) * (F.G / 8) + bx / 8 : bx; }
    unsigned char* ws = args.ws; F.ctl = (gu32*)(ws + WS_CTL);
    const float* x = args.in[0]; const float* norm_g = args.in[1]; const float* w_in = args.in[2]; const float* w_out = args.in[3]; const float* final_g = args.in[4];
    for (int u = F.tid; u < (EPI_OFF - LDSCTL_OFF) / 4; u += NWAVES * 64) ((LAS unsigned*)(F.lds + LDSCTL_OFF))[u] = 0u;
    __syncthreads();
    { const unsigned simd = (unsigned)__builtin_amdgcn_s_getreg((1 << 11) | (4 << 6) | 4) & 3u;
      if (F.lane == 0) F.MISC[16 + F.wave] = simd;
      __syncthreads();
      int rank = 0;
      for (int w = 0; w < NWAVES; ++w) { const unsigned sw = F.MISC[16 + w]; if (w < F.wave && sw == simd) ++rank; }
      F.grp = __builtin_amdgcn_readfirstlane(rank & 1); }
    XcdBarrier bar; bar.bar = (unsigned*)(F.ctl + CW_BAR); bar.x = 0; bar.st = nullptr;
    if (N_LAUNCHES == 1) bar = xcd_barrier_post((unsigned*)(F.ctl + CW_BAR), F.MISC + 8);
#define GRID_BAR() do { if (N_LAUNCHES == 1) xcd_barrier(bar); } while (0)
    const bool use_grp = (N_LAUNCHES == 1) && (F.G == 256);
    GrpBarrier gbar; { const unsigned g_ = blockIdx.x & 7u; gbar.arr = (unsigned*)(F.ctl + CW_GRP + 64 * g_); gbar.gen = (unsigned*)(F.ctl + CW_GRP + 512 + 64 * g_); gbar.tmo = (unsigned*)(F.ctl + CW_BAR); gbar.n = 32u; gbar.same = 0u; }
    if (use_grp && F.tid == 0) ((unsigned*)(F.ctl + CW_GRP + 1024))[blockIdx.x] = xb_xcc_id() + 1u;
#define GRP_BAR() do { if (use_grp && gbar.same) grp_barrier(gbar); else GRID_BAR(); } while (0)
    const int lo = args.ph_lo, hi = args.ph_hi;
#define IN(k) (lo <= (k) && (k) < hi)
#define BOTH(k) (IN(k) && IN((k) + 1))
    bf16* XB = (bf16*)(ws + WS_XB); bf16* QKVZ = (bf16*)(ws + WS_QKVZ); bf16* OG = (bf16*)(ws + WS_OG);
    const bf16* Qb = QKVZ; const bf16* Kb = QKVZ + TSTRIDE; const bf16* Vb = QKVZ + 2 * TSTRIDE; const bf16* Zb = QKVZ + 3 * TSTRIDE;
    float* rstd0 = (float*)(ws + WS_RSTD0); float* ssq1 = (float*)(ws + WS_SSQ1); float* ssq2 = (float*)(ws + WS_SSQ2); float* kmeanP = (float*)(ws + WS_KMEAN);
    PG8_LAS float* red = (PG8_LAS float*)(F.lds + EPI_OFF);

    if (IN(0)) REPS(0) { p0_prologue(F, x, norm_g, w_in, w_out, ws); if (BOTH(0)) GRID_BAR(); }
    if (use_grp && BOTH(0)) {
        if (F.tid < 64) {
            const unsigned* xt = (const unsigned*)(F.ctl + CW_GRP + 1024); unsigned ok = 1u;
#pragma unroll
            for (int q_ = 0; q_ < 4; ++q_) { const unsigned e_ = (unsigned)F.tid + 64u * q_; const unsigned v_ = xb_ld((unsigned*)xt + e_), r_ = xb_ld((unsigned*)xt + (e_ & 7u)); ok &= (v_ != 0u && v_ == r_) ? 1u : 0u; }
            const unsigned all_ok = __all(ok != 0u) ? 1u : 0u;
            if (F.tid == 0) F.MISC[12] = all_ok; }
        __syncthreads(); gbar.same = F.MISC[12]; }
    if (IN(1)) REPS(1) { desync_delay(GEMM_DESYNC_TICKS);
        pg8::Gemm g{XB, (const bf16*)(ws + WS_WIN), MROWS, NIN, DM}; pg8::StaticOrder S; S.init(MROWS, NIN, F.G, (int)blockIdx.x);
        pg8::EpiQKVZ<0> E{QKVZ, rstd0, nullptr, kmeanP};
        pg8::gemm_phase<pg8::EpiQKVZ<0>, pg8::StaticOrder, true, true>(F.lds + RING_OFF, g, S, E);
        if (BOTH(1)) GRP_BAR();
    }
    if (IN(2)) {
        bf16* PP0 = (bf16*)args.out; bf16* PP1 = (bf16*)args.out + (size_t)BATCH * NH * SEQ * HD; bf16* PP2 = XB;
        float* ML = (float*)(ws + WS_ML); mg::u16* lists = (mg::u16*)(ws + WS_LISTS); unsigned* lcnt = (unsigned*)(F.ctl + CW_LCNT);
        mg::mg_select(F.vcu, F.G, F.wave, F.lane, Qb, kmeanP, lcnt, lists);
        const bool pfc = (N_LAUNCHES == 1) && (F.G == 256);
        if (pfc && gbar.same) grp_barrier_pf(gbar, [&] { mg::mg_gather_prefetch((char*)lds + RING_OFF, F.vcu, F.G, Kb, Vb); });
        else if (pfc) xcd_barrier_pf(bar, [&] { mg::mg_gather_prefetch((char*)lds + RING_OFF, F.vcu, F.G, Kb, Vb); }); else GRID_BAR();
        for (int rp_ = 0; rp_ < ((MG_PROBE == 1) ? 2 : 1); ++rp_) mg::mg_gather<8>((char*)lds + RING_OFF, F.vcu, F.G, Qb, Kb, Vb, lcnt, lists, PP0, PP1, PP2, ML, pfc);
        if (pfc && gbar.same) grp_barrier_pf(gbar, [&] { mg::mg_own_prefetch((char*)lds + RING_OFF, F.vcu, F.G, Kb, Vb); });
        else if (pfc) xcd_barrier_pf(bar, [&] { mg::mg_own_prefetch((char*)lds + RING_OFF, F.vcu, F.G, Kb, Vb); }); else GRID_BAR();
        for (int rp_ = 0; rp_ < ((MG_PROBE == 2) ? 2 : 1); ++rp_) mg::mg_own<8>((char*)lds + RING_OFF, F.vcu, F.G, Qb, Kb, Vb, Zb, PP0, PP1, PP2, ML, OG, pfc);
        if (BOTH(2)) GRP_BAR();
    }
    if (IN(3)) REPS(3) { desync_delay(GEMM_DESYNC_TICKS);
        pg8::Gemm g{OG, (const bf16*)(ws + WS_WOUT), MROWS, DM, DM}; pg8::StaticOrder S; S.init(MROWS, DM, F.G, (int)blockIdx.x);
        pg8::EpiRes<0> E{x, nullptr, nullptr, XB, ssq1, red};
        pg8::gemm_phase<pg8::EpiRes<0>, pg8::StaticOrder, true, true>(F.lds + RING_OFF, g, S, E);
        if (BOTH(3)) GRP_BAR();
    }
    if (IN(4)) REPS(4) { desync_delay(GEMM_DESYNC_TICKS);
        pg8::Gemm g{XB, (const bf16*)(ws + WS_WIN) + (size_t)NIN * DM, MROWS, NIN, DM}; pg8::StaticOrder S; S.init(MROWS, NIN, F.G, (int)blockIdx.x);
        pg8::EpiQKVZ<1> E{QKVZ, nullptr, ssq1, nullptr};
        pg8::gemm_phase<pg8::EpiQKVZ<1>, pg8::StaticOrder, true, true>(F.lds + RING_OFF, g, S, E);
        if (BOTH(4)) GRP_BAR();
    }
    if (IN(5)) REPS(5) { sbk::sb_phase((char*)lds + RING_OFF, F.vcu, F.G, Qb, Kb, Vb, Zb, OG); if (BOTH(5)) GRID_BAR(); }
    if (IN(6)) { desync_delay(GEMM_DESYNC_TICKS);
        pg8::Gemm g{OG, (const bf16*)(ws + WS_WOUT) + (size_t)DM * DM, MROWS, DM, DM}; pg8::StaticOrder S; S.init(MROWS, DM, F.G, (int)blockIdx.x);
        pg8::EpiFinal E{XB, args.out, final_g, ssq2, (unsigned*)(F.ctl + CW_SEAM), red};
        pg8::gemm_phase<pg8::EpiFinal, pg8::StaticOrder, true, true>(F.lds + RING_OFF, g, S, E);
    }
#undef IN
#undef BOTH
}

extern "C" void kernel_launch(void* const* d_in, const int* in_sizes, int n_in, void* d_out, int out_size, void* d_ws, size_t ws_size, hipStream_t stream) {
    static int grid = 0;
    if (grid == 0) {
        if (n_in != 5 || in_sizes[0] != MROWS * DM || out_size != MROWS * DM || ws_size < WS_END) { fprintf(stderr, "kernel_launch: unexpected shapes (n_in %d, in0 %d, out %d, ws %zu); nothing launched\n", n_in, n_in > 0 ? in_sizes[0] : -1, out_size, ws_size); grid = -1; return; }
        int dev = 0, cus = 0, per_cu = 0;
        if (hipGetDevice(&dev) != hipSuccess || hipDeviceGetAttribute(&cus, hipDeviceAttributeMultiprocessorCount, dev) != hipSuccess) { fprintf(stderr, "kernel_launch: device query failed\n"); grid = -1; return; }
        if (hipFuncSetAttribute((const void*)trunk_fwd, hipFuncAttributeMaxDynamicSharedMemorySize, LDS_BYTES) != hipSuccess) { fprintf(stderr, "kernel_launch: hipFuncSetAttribute failed\n"); grid = -1; return; }
        if (hipOccupancyMaxActiveBlocksPerMultiprocessor(&per_cu, (const void*)trunk_fwd, NWAVES * 64, LDS_BYTES) != hipSuccess || per_cu < 1) fprintf(stderr, "kernel_launch: note: occupancy query reports %d workgroups per CU\n", per_cu);
        (void)hipGetLastError();
        grid = cus;
    }
    if (grid < 0) return;
    if (hipMemsetAsync((char*)d_ws + WS_CTL, 0, CTL_ZERO_BYTES, stream) != hipSuccess) { fprintf(stderr, "kernel_launch: hipMemsetAsync failed\n"); return; }
    Args a{};
    for (int i = 0; i < 5; ++i) a.in[i] = (const float*)d_in[i];
    a.out = (float*)d_out; a.ws = (unsigned char*)d_ws;
    for (int li = 0; li < N_LAUNCHES; ++li) {
        a.ph_lo = (N_LAUNCHES == 1) ? 0 : li; a.ph_hi = (N_LAUNCHES == 1) ? PER_PHASE : li + 1;
        hipLaunchKernelGGL(trunk_fwd, dim3(grid), dim3(NWAVES * 64), LDS_BYTES, stream, a);
        const hipError_t le = hipPeekAtLastError();
        if (le != hipSuccess) { fprintf(stderr, "kernel_launch: launch %d failed: %s\n", li, hipGetErrorName(le)); break; }
    }
}
```
